# Optimizing an MI355X kernel written in HIP

```python
import math
import jax, jax.numpy as jnp
from jax import lax
import numpy as np

D_MODEL = 1024
BATCH = 2
SEQ = 8192
DEPTH = 2

HEAD_DIM = 64
D_PLE = 256
A_WIDTH = D_MODEL // 2
A_HEADS = A_WIDTH // HEAD_DIM
MOBA_BLOCK = 256
MOBA_TOPK = 3
Q_BLOCK = 128
REL_BUCKETS = 32
REL_MAX_DIST = 128
B_WIDTH = D_MODEL // 4
POOL_WINDOWS = (2, 4, 8, 16)
B_GROUPS = len(POOL_WINDOWS)
B_GROUP = B_WIDTH // B_GROUPS
C_WIDTH = D_MODEL // 4
C_HEADS = C_WIDTH // HEAD_DIM
SGU_CHUNK = 128

D_MIX = A_WIDTH + B_WIDTH + C_WIDTH
IN_WIDTHS = (A_WIDTH,) * 4 + (B_WIDTH,) * 2 + (C_WIDTH,) * 3
D_IN = sum(IN_WIDTHS)
EPS = 1e-6
NEG = -1e30

kernel_name = "hybrid_moba_pool_sgu_trunk"


def rms_norm(x, g):
    x32 = x.astype(jnp.float32)
    y = x32 * lax.rsqrt(jnp.mean(x32 * x32, axis=-1, keepdims=True) + EPS)
    return (y * g.astype(jnp.float32)).astype(x.dtype)


def t5_bucket(n):
    max_exact = REL_BUCKETS // 2
    nf = jnp.maximum(n, 1).astype(jnp.float32)
    large = max_exact + (jnp.log(nf / max_exact) / math.log(REL_MAX_DIST / max_exact)
                         * (REL_BUCKETS - max_exact)).astype(jnp.int32)
    large = jnp.minimum(large, REL_BUCKETS - 1)
    return jnp.where(n < max_exact, n, large)


def moba_attention(q, k, v, rel_bias):
    B, S, H, D = q.shape
    nb = -(-S // MOBA_BLOCK)
    pad = nb * MOBA_BLOCK - S
    topk = min(MOBA_TOPK, nb)
    scale = D ** -0.5
    qh = jnp.transpose(q, (0, 2, 1, 3))
    kh = jnp.pad(jnp.transpose(k, (0, 2, 1, 3)), ((0, 0), (0, 0), (0, pad), (0, 0)))
    vh = jnp.pad(jnp.transpose(v, (0, 2, 1, 3)), ((0, 0), (0, 0), (0, pad), (0, 0)))
    k_blocks = kh.reshape(B, H, nb, MOBA_BLOCK, D)
    v_blocks = vh.reshape(B, H, nb, MOBA_BLOCK, D)
    k_mean = jnp.mean(k_blocks.astype(jnp.float32), axis=3)
    bias_tab = jnp.transpose(rel_bias).astype(jnp.float32)
    b_ix = jnp.arange(B)[:, None, None, None]
    h_ix = jnp.arange(H)[None, :, None, None]
    h_ix5 = jnp.arange(H)[None, :, None, None, None]
    blk_ids = jnp.arange(nb)
    in_blk = jnp.arange(MOBA_BLOCK)

    def q_block(qi):
        start = qi * Q_BLOCK
        qb = lax.dynamic_slice_in_dim(qh, start, Q_BLOCK, axis=2).astype(jnp.float32)
        t = start + jnp.arange(Q_BLOCK)
        own = start // MOBA_BLOCK
        gate = jnp.einsum('bhqd,bhnd->bhqn', qb, k_mean)
        gate = jnp.where(blk_ids < own, gate, NEG)
        top_val, top_idx = lax.top_k(gate, topk)
        sel_valid = top_val > NEG * 0.5
        k_sel = k_blocks[b_ix, h_ix, top_idx].astype(jnp.float32)
        v_sel = v_blocks[b_ix, h_ix, top_idx].astype(jnp.float32)
        sel_pos = top_idx[..., None] * MOBA_BLOCK + in_blk
        sel_bias = bias_tab[h_ix5, t5_bucket(t[:, None, None] - sel_pos)]
        sel_logits = jnp.einsum('bhqd,bhqnkd->bhqnk', qb, k_sel) * scale + sel_bias
        sel_logits = jnp.where(sel_valid[..., None], sel_logits, NEG)
        k_own = lax.dynamic_slice_in_dim(kh, own * MOBA_BLOCK, MOBA_BLOCK, axis=2).astype(jnp.float32)
        v_own = lax.dynamic_slice_in_dim(vh, own * MOBA_BLOCK, MOBA_BLOCK, axis=2).astype(jnp.float32)
        rel = t[:, None] - (own * MOBA_BLOCK + in_blk)[None, :]
        own_bias = bias_tab[:, t5_bucket(jnp.maximum(rel, 0))][None]
        own_logits = jnp.einsum('bhqd,bhkd->bhqk', qb, k_own) * scale + own_bias
        own_logits = jnp.where(rel >= 0, own_logits, NEG)
        logits = jnp.concatenate(
            [sel_logits.reshape(B, H, Q_BLOCK, topk * MOBA_BLOCK), own_logits], axis=-1)
        probs = jax.nn.softmax(logits, axis=-1)
        p_sel = probs[..., :topk * MOBA_BLOCK].reshape(B, H, Q_BLOCK, topk, MOBA_BLOCK)
        p_own = probs[..., topk * MOBA_BLOCK:]
        out = (jnp.einsum('bhqnk,bhqnkd->bhqd', p_sel, v_sel)
               + jnp.einsum('bhqk,bhkd->bhqd', p_own, v_own))
        return out.astype(q.dtype)

    outs = lax.map(q_block, jnp.arange(S // Q_BLOCK))
    return jnp.transpose(outs, (1, 0, 3, 2, 4)).reshape(B, S, H * D)


def multiscale_pool(xb, w_pool, pool_scale):
    B, S, C = xb.shape
    x32 = xb.astype(jnp.float32)
    cs = jnp.cumsum(x32, axis=1)
    count = jnp.arange(1, S + 1, dtype=jnp.float32)[None, :, None]
    groups = []
    for gi, w in enumerate(POOL_WINDOWS):
        c = cs[..., gi * B_GROUP:(gi + 1) * B_GROUP]
        lag = jnp.pad(c, ((0, 0), (w, 0), (0, 0)))[:, :S]
        mean = (c - lag) / jnp.minimum(count, float(w))
        groups.append(mean - x32[..., gi * B_GROUP:(gi + 1) * B_GROUP])
    pooled = jnp.stack(groups, axis=2)
    mixed = jnp.einsum('bsgc,gcd->bsgd', pooled, w_pool.astype(jnp.float32)).reshape(B, S, C)
    return (mixed * pool_scale.astype(jnp.float32)).astype(xb.dtype)


def spatial_gating(u, v, w_s, b_s):
    B, S, C = v.shape
    v32 = v.astype(jnp.float32)
    mu = jnp.mean(v32, axis=-1, keepdims=True)
    var = jnp.mean(jnp.square(v32 - mu), axis=-1, keepdims=True)
    vn = ((v32 - mu) * lax.rsqrt(var + EPS)).reshape(B, S // SGU_CHUNK, SGU_CHUNK, C_HEADS, C // C_HEADS)
    w_c = jnp.tril(w_s.astype(jnp.float32))
    mixed = (jnp.einsum('hts,bnshc->bnthc', w_c, vn)
             + jnp.transpose(b_s.astype(jnp.float32))[None, None, :, :, None])
    return (u.astype(jnp.float32) * mixed.reshape(B, S, C)).astype(u.dtype)


def setup_inputs(seed: int = 0) -> dict:
    key = jax.random.key(seed)
    ks = jax.random.split(key, 14)
    f32 = jnp.float32
    T = SGU_CHUNK
    return {
        'x': jax.random.normal(ks[0], (BATCH, SEQ, D_MODEL), f32),
        'p': jax.random.normal(ks[1], (DEPTH, BATCH, SEQ, D_PLE), f32),
        'norm_g': 1.0 + 0.1 * jax.random.normal(ks[2], (DEPTH, D_MODEL), f32),
        'w_in': jax.random.normal(ks[3], (DEPTH, D_MODEL, D_IN), f32) * D_MODEL ** -0.5,
        'w_out': jax.random.normal(ks[4], (DEPTH, D_MIX, D_MODEL), f32) * D_MIX ** -0.5,
        'rel_bias': 0.5 * jax.random.normal(ks[5], (REL_BUCKETS, A_HEADS), f32),
        'pool_w': jax.random.normal(ks[6], (DEPTH, B_GROUPS, B_GROUP, B_GROUP), f32) * B_GROUP ** -0.5,
        'pool_scale': 1.0 + 0.1 * jax.random.normal(ks[7], (DEPTH, B_WIDTH), f32),
        'sgu_w': jax.random.normal(ks[8], (DEPTH, C_HEADS, T, T), f32) * T ** -0.5,
        'sgu_b': 1.0 + 0.1 * jax.random.normal(ks[9], (DEPTH, C_HEADS, T), f32),
        'ple_w': jax.random.normal(ks[10], (DEPTH, D_PLE, D_MODEL), f32) * D_PLE ** -0.5,
        'ple_gate_w': jax.random.normal(ks[11], (DEPTH, D_MODEL, D_MODEL), f32) * D_MODEL ** -0.5,
        'final_g': 1.0 + 0.1 * jax.random.normal(ks[12], (D_MODEL,), f32),
    }


def reference(x, p, norm_g, w_in, w_out, rel_bias, pool_w, pool_scale, sgu_w, sgu_b,
              ple_w, ple_gate_w, final_g):
    B, S, _ = x.shape
    split_at = [int(s) for s in np.cumsum(IN_WIDTHS)[:-1]]
    h = x
    for i in range(DEPTH):
        hn = rms_norm(h, norm_g[i])
        z = hn @ w_in[i]
        qa, ka, va, ga, xb, gb, uc, vc, gc = jnp.split(z, split_at, axis=-1)
        ya = moba_attention(qa.reshape(B, S, A_HEADS, HEAD_DIM),
                            ka.reshape(B, S, A_HEADS, HEAD_DIM),
                            va.reshape(B, S, A_HEADS, HEAD_DIM), rel_bias) * jax.nn.silu(ga)
        yb = multiscale_pool(xb, pool_w[i], pool_scale[i]) * jax.nn.silu(gb)
        yc = spatial_gating(uc, vc, sgu_w[i], sgu_b[i]) * jax.nn.silu(gc)
        h = h + jnp.concatenate([ya, yb, yc], axis=-1) @ w_out[i]
        h = h + (p[i] @ ple_w[i]) * jax.nn.sigmoid(h @ ple_gate_w[i])
    return rms_norm(h, final_g)
```

```cpp
#include <hip/hip_runtime.h>
#include <cstdio>
#include <cstdint>
namespace pg8 {
#define PG8_LAS __attribute__((address_space(3)))
typedef unsigned short bf16_t;
typedef short bf16x8 __attribute__((ext_vector_type(8)));
typedef float f32x4 __attribute__((ext_vector_type(4)));
typedef unsigned u32x4 __attribute__((ext_vector_type(4)));
constexpr int BM = 256, BK = 64, HALF = 128, HTB = HALF * BK * 2  , STAGE_BYTES = 8 * HTB, NXCD = 8, WGM = 8;

__host__ __device__ __forceinline__ int lds_byte(int r, int c) { const int st = (r >> 4) * 2 + (c >> 5), rr = r & 15, cc = c & 31, ob = rr * 64 + cc * 2; return st * 1024 + (ob ^ (((ob >> 9) & 1) << 5)); }
__host__ __device__ __forceinline__ void stage_rc(int b, int& R, int& C) { const int st = b / 1024, sb = b % 1024, swz = sb ^ (((sb >> 9) & 1) << 5); R = (st >> 1) * 16 + swz / 64; C = (st & 1) * 32 + (swz % 64) / 2; }
__host__ __device__ __forceinline__ int perm32(int rho) { const int n = rho >> 4, i = rho & 15; return 8 * (i >> 2) + 4 * n + (i & 3); }

struct Unit { int pm, pn; };
struct Gemm { const bf16_t* A; const bf16_t* Bt; int M, N, K; };

struct StaticOrder {
    int nM, nN, nwg, G, c;
    __host__ __device__ void init(int M, int N, int G_, int c_) { nM = M / BM; nN = N / BM; nwg = nM * nN; G = G_; c = c_; }
    __host__ __device__ bool next(int i, Unit& u) const {
        const long L = (long)i * G + c; if (L >= nwg) return false;
        int wgid = (int)L; { const int q = nwg / NXCD, r = nwg % NXCD, xcd = wgid % NXCD, off = wgid / NXCD; wgid = (xcd < r ? xcd * (q + 1) : r * (q + 1) + (xcd - r) * q) + off; }
        const int nig = WGM * nN, gid = wgid / nig, fm = gid * WGM, gsz = (nM - fm) < WGM ? (nM - fm) : WGM;
        u.pm = fm + ((wgid % nig) % gsz); u.pn = (wgid % nig) / gsz; return true;
    }
    __device__ __forceinline__ void a_ready(const Unit&) const {}
    __device__ __forceinline__ void done(const Unit&) const {}
};

typedef float f32x2_t __attribute__((ext_vector_type(2))); typedef __bf16 bf16x2_t __attribute__((ext_vector_type(2)));
__device__ __forceinline__ unsigned cvt_pk_bf16(float lo, float hi) { f32x2_t v = {lo, hi}; bf16x2_t b = __builtin_convertvector(v, bf16x2_t); return __builtin_bit_cast(unsigned, b); }
__device__ __forceinline__ float bf_lo(unsigned w) { return __uint_as_float(w << 16); }
__device__ __forceinline__ float bf_hi(unsigned w) { return __uint_as_float(w & 0xffff0000u); }
typedef unsigned u32x2 __attribute__((ext_vector_type(2)));

struct EpiZ {
    static constexpr bool PERM = true, AFTER_DRAIN = false;
    bf16_t* Z; const float* ssq; float* ksum; float qscale; int ldz;
    __device__ __forceinline__ void operator()(const f32x4 (&acc)[2][2][4][2], const Unit& u, int wr, int wc, int fr, int fq) const {
        const int row0 = u.pm * BM + wr * 64 + fr, col0 = u.pn * BM + wc * 32 + 8 * fq;
        const float sc = (u.pn < 2) ? qscale : 1.f;
        const bool ktile = (u.pn == 2 || u.pn == 3);
        float cs[2][8];
#pragma unroll
        for (int bj = 0; bj < 2; ++bj)
#pragma unroll
            for (int i = 0; i < 8; ++i) cs[bj][i] = 0.f;
#pragma unroll
        for (int ai = 0; ai < 2; ++ai)
#pragma unroll
            for (int m = 0; m < 4; ++m) {
                const int row = row0 + ai * HALF + m * 16;
                const f32x4 s4 = *(const f32x4*)(ssq + (size_t)row * 4);
                const float rs = __builtin_amdgcn_rsqf(((s4[0] + s4[1]) + (s4[2] + s4[3])) * (1.0f / 1024.0f) + 1e-6f) * sc;
                bf16_t* rowp = Z + (size_t)row * ldz + col0;
#pragma unroll
                for (int bj = 0; bj < 2; ++bj) {
                    const f32x4 v0 = acc[ai][bj][m][0] * rs, v1 = acc[ai][bj][m][1] * rs;
                    u32x4 w; w.x = cvt_pk_bf16(v0[0], v0[1]); w.y = cvt_pk_bf16(v0[2], v0[3]); w.z = cvt_pk_bf16(v1[0], v1[1]); w.w = cvt_pk_bf16(v1[2], v1[3]);
                    *(u32x4*)(rowp + bj * HALF) = w;
                    if (ktile) {
#pragma unroll
                        for (int i = 0; i < 4; ++i) { cs[bj][i] += v0[i]; cs[bj][4 + i] += v1[i]; }
                    }
                }
            }
        if (ktile) {
#pragma unroll
            for (int bj = 0; bj < 2; ++bj)
#pragma unroll
                for (int i = 0; i < 8; ++i) {
                    float v = cs[bj][i];
                    v += __shfl_xor(v, 1); v += __shfl_xor(v, 2); v += __shfl_xor(v, 4); v += __shfl_xor(v, 8);
                    if (fr == 0) atomicAdd(ksum + (size_t)u.pm * 512 + (u.pn - 2) * 256 + bj * HALF + wc * 32 + 8 * fq + i, v);
                }
        }
    }
};
struct EpiRes {
    static constexpr bool PERM = false, AFTER_DRAIN = false;
    const float* base; float* out; bf16_t* hb;
    __device__ __forceinline__ void operator()(const f32x4 (&acc)[2][2][4][2], const Unit& u, int wr, int wc, int fr, int fq) const {
        const int col0 = u.pn * BM + wc * 32 + 4 * fq;
#pragma unroll
        for (int ai = 0; ai < 2; ++ai)
#pragma unroll
            for (int m = 0; m < 4; ++m) {
                const size_t off = (size_t)(u.pm * BM + ai * HALF + wr * 64 + m * 16 + fr) * 1024 + col0;
#pragma unroll
                for (int bj = 0; bj < 2; ++bj)
#pragma unroll
                    for (int n = 0; n < 2; ++n) {
                        const f32x4 o = *(const f32x4*)(base + off + bj * HALF + n * 16) + acc[ai][bj][m][n];
                        *(f32x4*)(out + off + bj * HALF + n * 16) = o;
                        u32x2 w; w.x = cvt_pk_bf16(o[0], o[1]); w.y = cvt_pk_bf16(o[2], o[3]);
                        *(u32x2*)(hb + off + bj * HALF + n * 16) = w;
                    }
            }
    }
};
struct EpiSig {
    static constexpr bool PERM = true, AFTER_DRAIN = false;
    bf16_t* T;
    __device__ __forceinline__ void operator()(const f32x4 (&acc)[2][2][4][2], const Unit& u, int wr, int wc, int fr, int fq) const {
        const int row0 = u.pm * BM + wr * 64 + fr, col0 = u.pn * BM + wc * 32 + 8 * fq;
#pragma unroll
        for (int ai = 0; ai < 2; ++ai)
#pragma unroll
            for (int m = 0; m < 4; ++m) {
                bf16_t* rowp = T + (size_t)(row0 + ai * HALF + m * 16) * 1024 + col0;
#pragma unroll
                for (int bj = 0; bj < 2; ++bj) {
                    f32x4 v0 = acc[ai][bj][m][0], v1 = acc[ai][bj][m][1];
#pragma unroll
                    for (int i = 0; i < 4; ++i) { v0[i] = __builtin_amdgcn_rcpf(1.f + __expf(-v0[i])); v1[i] = __builtin_amdgcn_rcpf(1.f + __expf(-v1[i])); }
                    u32x4 w; w.x = cvt_pk_bf16(v0[0], v0[1]); w.y = cvt_pk_bf16(v0[2], v0[3]); w.z = cvt_pk_bf16(v1[0], v1[1]); w.w = cvt_pk_bf16(v1[2], v1[3]);
                    *(u32x4*)(rowp + bj * HALF) = w;
                }
            }
    }
};
struct EpiPle {
    static constexpr bool PERM = true, AFTER_DRAIN = true;
    const bf16_t* T; float* out; bf16_t* xn; const float* gnext; float* ssq;
    __device__ __forceinline__ void fused(f32x4 (&acc)[2][2][4][2], const Unit& u, int wr, int wc, int fr, int fq, PG8_LAS unsigned char* lds, int wid, int lane) const {
        PG8_LAS float* P = (PG8_LAS float*)lds;
        const int row0 = u.pm * BM + wr * 64 + fr, col0 = u.pn * BM + wc * 32 + 8 * fq;
        f32x4 gv[2][2];
#pragma unroll
        for (int bj = 0; bj < 2; ++bj) { gv[bj][0] = *(const f32x4*)(gnext + col0 + bj * HALF); gv[bj][1] = *(const f32x4*)(gnext + col0 + bj * HALF + 4); }
#pragma unroll
        for (int ai = 0; ai < 2; ++ai)
#pragma unroll
            for (int m = 0; m < 4; ++m) {
                const int rl = ai * HALF + wr * 64 + m * 16 + fr;
                const size_t off = (size_t)(u.pm * BM + rl) * 1024 + col0;
                float q = 0.f;
#pragma unroll
                for (int bj = 0; bj < 2; ++bj) {
                    const u32x4 sw = *(const u32x4*)(T + off + bj * HALF);
                    const f32x4 h0 = *(const f32x4*)(out + off + bj * HALF), h1 = *(const f32x4*)(out + off + bj * HALF + 4);
                    const f32x4 s0 = (f32x4){bf_lo(sw.x), bf_hi(sw.x), bf_lo(sw.y), bf_hi(sw.y)}, s1 = (f32x4){bf_lo(sw.z), bf_hi(sw.z), bf_lo(sw.w), bf_hi(sw.w)};
                    const f32x4 o0 = h0 + acc[ai][bj][m][0] * s0, o1 = h1 + acc[ai][bj][m][1] * s1;
                    *(f32x4*)(out + off + bj * HALF) = o0; *(f32x4*)(out + off + bj * HALF + 4) = o1;
                    q += (o0[0] * o0[0] + o0[1] * o0[1]) + (o0[2] * o0[2] + o0[3] * o0[3]) + (o1[0] * o1[0] + o1[1] * o1[1]) + (o1[2] * o1[2] + o1[3] * o1[3]);
                    const f32x4 x0 = o0 * gv[bj][0], x1 = o1 * gv[bj][1];
                    u32x4 w; w.x = cvt_pk_bf16(x0[0], x0[1]); w.y = cvt_pk_bf16(x0[2], x0[3]); w.z = cvt_pk_bf16(x1[0], x1[1]); w.w = cvt_pk_bf16(x1[2], x1[3]);
                    *(u32x4*)(xn + off + bj * HALF) = w;
                }
                q += __shfl_xor(q, 16); q += __shfl_xor(q, 32);
                if (fq == 0) P[rl * 4 + wc] = q;
            }
        asm volatile("s_waitcnt lgkmcnt(0)" ::: "memory"); __builtin_amdgcn_s_barrier(); asm volatile("" ::: "memory");
        const int t = wid * 64 + lane;
        if (t < 256) { const float s = (P[t * 4 + 0] + P[t * 4 + 1]) + (P[t * 4 + 2] + P[t * 4 + 3]); ssq[(size_t)(u.pm * BM + t) * 4 + u.pn] = s; }
        asm volatile("s_waitcnt lgkmcnt(0)" ::: "memory"); __builtin_amdgcn_s_barrier(); asm volatile("" ::: "memory");
    }
};

template <class Epi, class Sched, bool ALIGN_EPI = false, bool SP2 = false>
__device__ __forceinline__ void gemm_phase(PG8_LAS unsigned char* lds, const Gemm g, const Sched& S, const Epi& E) {
    const int tid = threadIdx.x, wid = __builtin_amdgcn_readfirstlane(tid >> 6), lane = tid & 63, wr = wid >> 2, wc = wid & 3, fr = lane & 15, fq = lane >> 4;
    const int K = g.K, nt = K / BK;
    unsigned voffA[2], voffB[2];
#pragma unroll
    for (int i = 0; i < 2; ++i) { int R, C; stage_rc(tid * 16 + i * 8192, R, C); const int Rb = Epi::PERM ? ((R & ~31) + perm32(R & 31)) : R;
        voffA[i] = (unsigned)(R * K + C) * 2u; voffB[i] = (unsigned)(Rb * K + C) * 2u; }
    const size_t kstep = (size_t)(BK * 2);
    const size_t hstep = (size_t)HALF * K * 2;
    const size_t tstep = 2 * hstep;
    const unsigned ldsw = (unsigned)wid * 1024u;
    const int aoff = lds_byte(wr * 64 + fr, fq * 8), boff = lds_byte(wc * 32 + fr, fq * 8);
#define PG8_SA(b, h) (((b) * 2 + (h)) * HTB)
#define PG8_SB(b, h) ((4 + (b) * 2 + (h)) * HTB)
#define PG8_STAGE(bufoff, gbase, voff) do { _Pragma("unroll") for (int _i = 0; _i < 2; ++_i) \
        __builtin_amdgcn_global_load_lds((const unsigned*)((const char*)(gbase) + (voff)[_i]), (PG8_LAS unsigned*)(lds + (bufoff) + ldsw + _i * 8192), 16, 0, 0); } while (0)
#define PG8_LDA(dst, b, h) do { _Pragma("unroll") for (int m = 0; m < 4; ++m) _Pragma("unroll") for (int k = 0; k < 2; ++k) dst[m][k] = *(const PG8_LAS bf16x8*)(lds + PG8_SA(b, h) + aoff + m * 2048 + k * 1024); } while (0)
#define PG8_LDB(dst, b, h) do { _Pragma("unroll") for (int n = 0; n < 2; ++n) _Pragma("unroll") for (int k = 0; k < 2; ++k) dst[n][k] = *(const PG8_LAS bf16x8*)(lds + PG8_SB(b, h) + boff + n * 2048 + k * 1024); } while (0)
#define PG8_MMA(ai, bj, At, Bt) do { __builtin_amdgcn_s_setprio(1); _Pragma("unroll") for (int m = 0; m < 4; ++m) _Pragma("unroll") for (int n = 0; n < 2; ++n) _Pragma("unroll") for (int k = 0; k < 2; ++k) \
        acc[ai][bj][m][n] = __builtin_amdgcn_mfma_f32_16x16x32_bf16(Bt[n][k], At[m][k], acc[ai][bj][m][n], 0, 0, 0); __builtin_amdgcn_s_setprio(0); } while (0)
#define PG8_WAIT_V(n) asm volatile("s_waitcnt vmcnt(" #n ")" ::: "memory")
#define PG8_WAIT_L(n) asm volatile("s_waitcnt lgkmcnt(" #n ")" ::: "memory")
#define PG8_BAR __builtin_amdgcn_s_barrier()
#define PG8_SCHED __builtin_amdgcn_sched_barrier(0)
    Unit cur, nxt; int ui = 0;
    if (!S.next(0, cur)) return;
    f32x4 acc[2][2][4][2];
#pragma unroll
    for (int a = 0; a < 2; ++a)
#pragma unroll
        for (int b = 0; b < 2; ++b)
#pragma unroll
            for (int m = 0; m < 4; ++m)
#pragma unroll
                for (int n = 0; n < 2; ++n) acc[a][b][m][n] = (f32x4){0.f, 0.f, 0.f, 0.f};
    bf16x8 At[4][2], B0[2][2], B1[2][2];
    const char* cA = (const char*)g.A + (size_t)cur.pm * tstep; const char* cB = (const char*)g.Bt + (size_t)cur.pn * tstep;
    S.a_ready(cur);
    if constexpr (SP2) {
        PG8_STAGE(PG8_SB(0, 0), cB, voffB); PG8_STAGE(PG8_SB(0, 1), cB + hstep, voffB); PG8_STAGE(PG8_SA(0, 0), cA, voffA); PG8_STAGE(PG8_SA(0, 1), cA + hstep, voffA);
        if (wr == 1) PG8_BAR;
        PG8_WAIT_V(2); PG8_BAR;
        PG8_STAGE(PG8_SB(1, 0), cB + kstep, voffB); PG8_STAGE(PG8_SA(1, 0), cA + kstep, voffA); PG8_STAGE(PG8_SB(1, 1), cB + hstep + kstep, voffB);
        PG8_WAIT_V(6); PG8_BAR;
    } else {
        PG8_STAGE(PG8_SB(0, 0), cB, voffB); PG8_STAGE(PG8_SA(0, 0), cA, voffA); PG8_STAGE(PG8_SB(0, 1), cB + hstep, voffB); PG8_STAGE(PG8_SA(0, 1), cA + hstep, voffA);
        if (wr == 1) PG8_BAR;
        PG8_WAIT_V(4); PG8_BAR;
        PG8_STAGE(PG8_SB(1, 0), cB + kstep, voffB); PG8_STAGE(PG8_SA(1, 0), cA + kstep, voffA); PG8_STAGE(PG8_SB(1, 1), cB + hstep + kstep, voffB);
        PG8_WAIT_V(6); PG8_BAR;
    }
    for (;;) {
        const bool has_next = S.next(ui + 1, nxt);
        const char* nA = has_next ? (const char*)g.A + (size_t)nxt.pm * tstep : cA; const char* nB = has_next ? (const char*)g.Bt + (size_t)nxt.pn * tstep : cB;
        for (int t = 0; t < nt; t += 2) {
            const bool last = (t == nt - 2);
            const char* a1 = cA + (size_t)(t + 1) * kstep;
            const char* a2 = last ? nA : cA + (size_t)(t + 2) * kstep; const char* b2 = last ? nB : cB + (size_t)(t + 2) * kstep;
            const char* a3 = a2 + kstep; const char* b3 = b2 + kstep;
            if (last && has_next) S.a_ready(nxt);
            if constexpr (SP2) {
            PG8_LDB(B0, 0, 0); PG8_LDB(B1, 0, 1); PG8_SCHED; PG8_LDA(At, 0, 0); PG8_STAGE(PG8_SA(1, 1), a1 + hstep, voffA);
            PG8_WAIT_V(8); PG8_WAIT_L(0); PG8_BAR; PG8_MMA(0, 0, At, B0); PG8_MMA(0, 1, At, B1); PG8_BAR; PG8_SCHED;
            PG8_LDA(At, 0, 1); PG8_STAGE(PG8_SB(0, 0), b2, voffB); PG8_STAGE(PG8_SB(0, 1), b2 + hstep, voffB); PG8_STAGE(PG8_SA(0, 0), a2, voffA);
            PG8_WAIT_V(8); PG8_WAIT_L(0); PG8_BAR; PG8_MMA(1, 0, At, B0); PG8_MMA(1, 1, At, B1); PG8_BAR; PG8_SCHED;
            PG8_LDB(B0, 1, 0); PG8_LDB(B1, 1, 1); PG8_SCHED; PG8_LDA(At, 1, 0); PG8_STAGE(PG8_SA(0, 1), a2 + hstep, voffA);
            PG8_WAIT_V(8); PG8_WAIT_L(0); PG8_BAR; PG8_MMA(0, 0, At, B0); PG8_MMA(0, 1, At, B1); PG8_BAR; PG8_SCHED;
            PG8_LDA(At, 1, 1); PG8_STAGE(PG8_SB(1, 0), b3, voffB); PG8_STAGE(PG8_SB(1, 1), b3 + hstep, voffB); PG8_STAGE(PG8_SA(1, 0), a3, voffA);
            PG8_WAIT_V(8); PG8_WAIT_L(0); PG8_BAR; PG8_MMA(1, 0, At, B0); PG8_MMA(1, 1, At, B1); PG8_BAR; PG8_SCHED;
            } else {
            PG8_LDB(B0, 0, 0); PG8_SCHED; PG8_LDA(At, 0, 0); PG8_STAGE(PG8_SA(1, 1), a1 + hstep, voffA);
            PG8_WAIT_L(8); PG8_BAR; PG8_WAIT_L(0); PG8_MMA(0, 0, At, B0); PG8_BAR; PG8_SCHED;
            PG8_LDB(B1, 0, 1); PG8_STAGE(PG8_SB(0, 0), b2, voffB);
            PG8_BAR; PG8_WAIT_L(0); PG8_MMA(0, 1, At, B1); PG8_BAR;
            PG8_LDA(At, 0, 1); PG8_STAGE(PG8_SA(0, 0), a2, voffA);
            PG8_BAR; PG8_WAIT_L(0); PG8_MMA(1, 0, At, B0); PG8_BAR; PG8_SCHED;
            PG8_STAGE(PG8_SB(0, 1), b2 + hstep, voffB);
            PG8_WAIT_V(6); PG8_BAR; PG8_MMA(1, 1, At, B1); PG8_BAR;
            PG8_LDB(B0, 1, 0); PG8_SCHED; PG8_LDA(At, 1, 0); PG8_STAGE(PG8_SA(0, 1), a2 + hstep, voffA);
            PG8_WAIT_L(8); PG8_BAR; PG8_WAIT_L(0); PG8_MMA(0, 0, At, B0); PG8_BAR; PG8_SCHED;
            PG8_LDB(B1, 1, 1); PG8_STAGE(PG8_SB(1, 0), b3, voffB);
            PG8_BAR; PG8_WAIT_L(0); PG8_MMA(0, 1, At, B1); PG8_BAR;
            PG8_LDA(At, 1, 1); PG8_STAGE(PG8_SA(1, 0), a3, voffA);
            PG8_BAR; PG8_WAIT_L(0); PG8_MMA(1, 0, At, B0); PG8_BAR; PG8_SCHED;
            PG8_STAGE(PG8_SB(1, 1), b3 + hstep, voffB);
            PG8_WAIT_V(6); PG8_BAR; PG8_MMA(1, 1, At, B1); PG8_BAR;
            }
        }
        if constexpr (ALIGN_EPI) { if (wr == 0) PG8_BAR; }
        if constexpr (!Epi::AFTER_DRAIN) { E(acc, cur, wr, wc, fr, fq); S.done(cur); }
        if (!has_next) break;
#pragma unroll
        for (int a = 0; a < 2; ++a)
#pragma unroll
            for (int b = 0; b < 2; ++b)
#pragma unroll
                for (int m = 0; m < 4; ++m)
#pragma unroll
                    for (int n = 0; n < 2; ++n) acc[a][b][m][n] = (f32x4){0.f, 0.f, 0.f, 0.f};
        cur = nxt; cA = nA; cB = nB; ++ui;
        if constexpr (ALIGN_EPI) { if (wr == 1) PG8_BAR; }
    }
    PG8_WAIT_V(0);
    if constexpr (!ALIGN_EPI) { if (wr == 0) PG8_BAR; }
    PG8_BAR;
    if constexpr (Epi::AFTER_DRAIN) { E.fused(acc, cur, wr, wc, fr, fq, lds, wid, lane); S.done(cur); }
#undef PG8_SA
#undef PG8_SB
#undef PG8_STAGE
#undef PG8_LDA
#undef PG8_LDB
#undef PG8_MMA
#undef PG8_WAIT_V
#undef PG8_WAIT_L
#undef PG8_BAR
#undef PG8_SCHED
}
}

#ifndef PG8_SP2
#define PG8_SP2 true
#endif
#ifndef PG8_ALIGN
#define PG8_ALIGN true
#endif
constexpr int NWAVES = 8;
constexpr int BATCH = 2, SEQ = 8192, DM = 1024, M = BATCH * SEQ, DIN = 3328, DPLE = 256, NL = 2, NH = 8, HD = 64, NBLK = 32;
constexpr int ZQ = 0, ZK = 512, ZV = 1024, ZGA = 1536, ZXB = 2048, ZGB = 2304, ZUC = 2560, ZVC = 2816, ZGC = 3072;
constexpr float C2 = 0.125f * 1.4426950408889634f;
constexpr float LOG2E = 1.4426950408889634f;
constexpr int NBIAS = 129;
constexpr size_t MiB = 1u << 20, KiB = 1u << 10;
constexpr size_t WS_CTL = 0, CTL_ZERO_BYTES = 1 * MiB;
constexpr size_t CTL_KSUM = 512 * KiB;
constexpr size_t CTL_NTOT = 768 * KiB;
constexpr size_t WS_WIN = 1 * MiB, WIN_BYTES = (size_t)DIN * DM * 2;
constexpr size_t WS_WOUT = 14 * MiB, WS_WGATE = 18 * MiB, WS_WPLE = 22 * MiB;
constexpr size_t WS_SGUW = 23 * MiB;
constexpr size_t WS_POOLWT = 23 * MiB + 256 * KiB;
constexpr size_t WS_BIAS2 = 23 * MiB + 512 * KiB;
constexpr size_t WS_SSQ = 23 * MiB + 768 * KiB;
constexpr size_t WS_STATS = 24 * MiB;
constexpr size_t WS_PB = 26 * MiB;
constexpr size_t WS_XN = 42 * MiB;
constexpr size_t WS_Z = 74 * MiB;
constexpr size_t WS_OPART = 178 * MiB;
constexpr size_t WS_LSE = 242 * MiB;
constexpr size_t WS_H1B = 178 * MiB, WS_TB = 210 * MiB;
constexpr size_t WS_LISTS = 244 * MiB;
constexpr size_t WS_CNT = 252 * MiB;
constexpr size_t WS_END = 253 * MiB;
constexpr int CW_TMO = 0, CW_CODE = 1, CW_BAR = 4096;
constexpr int RING_OFF = 0, RING_BYTES = 131072;
constexpr int LDSCTL_OFF = RING_BYTES, MISC_OFF = LDSCTL_OFF + 320;
constexpr int LDS_BYTES = 147456;

#define GAS __attribute__((address_space(1)))
#define LAS __attribute__((address_space(3)))
typedef unsigned short bf16;
typedef unsigned v4u __attribute__((ext_vector_type(4)));
typedef float f32x4 __attribute__((ext_vector_type(4)));
typedef short bf16x8 __attribute__((ext_vector_type(8)));
typedef GAS unsigned gu32;
typedef GAS unsigned long long gu64;
#define RLX_AGENT __ATOMIC_RELAXED, __HIP_MEMORY_SCOPE_AGENT
#define LDS_WAIT() asm volatile("s_waitcnt lgkmcnt(0)" ::: "memory")
#define VM_WAIT() asm volatile("s_waitcnt vmcnt(0)" ::: "memory")
__device__ __forceinline__ unsigned long long rt() { return __builtin_amdgcn_s_memrealtime(); }
__device__ __forceinline__ unsigned f2bf(float f) { unsigned u = __builtin_bit_cast(unsigned, f); return (u + 0x7fffu + ((u >> 16) & 1u)) >> 16; }
__device__ __forceinline__ unsigned pk2(float lo, float hi) { return f2bf(lo) | (f2bf(hi) << 16); }

#define XB_TMO      128
#define XB_XCNT(j)  (256  + 64 * (j))
#define XB_XSUB(j)  (1280 + 64 * (j))
#define XB_XGEN(j)  (2304 + 64 * (j))
#define XB_TOP      3328
#define XB_TOPGEN   3392
#define XCD_BAR_WORDS 3456
#define XB_SPIN_CAP (1u << 18)

__device__ __forceinline__ unsigned xb_ld(unsigned* p)              { return __hip_atomic_load(p, __ATOMIC_RELAXED, __HIP_MEMORY_SCOPE_AGENT); }
__device__ __forceinline__ unsigned xb_add(unsigned* p, unsigned v) { return __hip_atomic_fetch_add(p, v, __ATOMIC_RELAXED, __HIP_MEMORY_SCOPE_AGENT); }
__device__ __forceinline__ unsigned xb_xcc_id() { return (unsigned)__builtin_amdgcn_s_getreg((3 << 11) | 20) & 0xFu; }
#define XB_SPIN(cond, bar) do { unsigned _sp = 0; while (cond) { __builtin_amdgcn_s_sleep(1); \
    if ((++_sp & 255u) == 0u) { if (xb_ld(&(bar)[XB_TMO])) break; if (_sp > XB_SPIN_CAP) { atomicAdd(&(bar)[XB_TMO], 1u); break; } } } } while (0)

struct XcdBarrier {
    unsigned* bar; unsigned x;
    volatile LAS unsigned* st;
};

__device__ __forceinline__ XcdBarrier xcd_barrier_post(unsigned* bar, volatile LAS unsigned* st) {
    XcdBarrier b; b.bar = bar; b.x = xb_xcc_id(); b.st = st;
    if (threadIdx.x == 0) (void)xb_add(&bar[XB_XCNT(b.x)], 1u);
    return b;
}
__device__ __forceinline__ void xcd_barrier_complete(unsigned* bar, unsigned x, unsigned& nloc, unsigned& nx) {
    const unsigned G = gridDim.x * gridDim.y * gridDim.z;
    unsigned sum, cnt, mine, sp = 0u;
    for (;;) {
        sum = 0u; cnt = 0u; mine = 0u;
#pragma unroll
        for (unsigned j = 0; j < 16; ++j) { const unsigned c = xb_ld(&bar[XB_XCNT(j)]); sum += c; cnt += (c > 0u) ? 1u : 0u; mine = (j == x) ? c : mine; }
        if (sum == G) break;
        __builtin_amdgcn_s_sleep(1);
        if ((++sp & 255u) == 0u) { if (xb_ld(&bar[XB_TMO])) break; if (sp > XB_SPIN_CAP) { atomicAdd(&bar[XB_TMO], 1u); break; } }
    }
    nloc = mine > 0u ? mine : 1u; nx = cnt > 0u ? cnt : 1u;
}

__device__ __forceinline__ void xcd_barrier(const XcdBarrier& b) {
    asm volatile("s_waitcnt vmcnt(0)" ::: "memory");
    __syncthreads();
    if (threadIdx.x == 0) {
        unsigned* bar = b.bar;
        __builtin_amdgcn_s_waitcnt(0);
        unsigned nloc = b.st[0], nx = b.st[1];
        if (nloc == 0u) { xcd_barrier_complete(bar, b.x, nloc, nx); b.st[0] = nloc; b.st[1] = nx; }
        const unsigned old = xb_add(&bar[XB_XSUB(b.x)], 1u);
        const unsigned gen = old / nloc;
        if (old + 1u == (gen + 1u) * nloc) {
            __builtin_amdgcn_fence(__ATOMIC_RELEASE, "agent");
            asm volatile("s_waitcnt vmcnt(0)" ::: "memory");
            const unsigned og = xb_add(&bar[XB_TOP], 1u);
            const unsigned tg = og / nx;
            if (og + 1u == (tg + 1u) * nx) xb_add(&bar[XB_TOPGEN], 1u);
            else XB_SPIN(xb_ld(&bar[XB_TOPGEN]) == tg, bar);
            __builtin_amdgcn_fence(__ATOMIC_ACQUIRE, "agent");
            xb_add(&bar[XB_XGEN(b.x)], 1u);
            asm volatile("s_waitcnt vmcnt(0)" ::: "memory");
        } else {
            XB_SPIN(xb_ld(&bar[XB_XGEN(b.x)]) == gen, bar);
            __builtin_amdgcn_fence(__ATOMIC_ACQUIRE, "agent");
            asm volatile("s_waitcnt vmcnt(0)" ::: "memory");
        }
    }
    __syncthreads();
}
struct Frame {
    LAS unsigned char* lds;
    volatile LAS unsigned* MISC;
    gu32* ctl;
    int tid, lane, wave, vcu, G;
};
__device__ __forceinline__ float wave_sum(float v) {
#pragma unroll
    for (int o = 1; o < 64; o <<= 1) v += __shfl_xor(v, o);
    return v;
}
__device__ __forceinline__ float bf2f(bf16 v) { return __uint_as_float((unsigned)v << 16); }
__device__ __forceinline__ float silu_f(float x) { return x / (1.f + __expf(-x)); }
__device__ __forceinline__ int t5_bucket(int n) {
    if (n < 16) return n;
    const float v = logf((float)n / 16.f) / 2.0794415416798357f * 16.f;
    const int l = 16 + (int)v;
    return l < 31 ? l : 31;
}
__device__ __forceinline__ void p0_transpose_item(const float* W, int K, int N, bf16* WT, LAS float* scr, int item, int lane) {
    const int nblk = N / 32, kb = item / nblk, nb = item % nblk, k0 = 64 * kb, n0 = 32 * nb;
#pragma unroll 8
    for (int i = 0; i < 32; ++i) { const int kk = 2 * i + (lane >> 5); scr[kk * 33 + (lane & 31)] = W[(size_t)(k0 + kk) * N + n0 + (lane & 31)]; }
    LDS_WAIT(); asm volatile("" ::: "memory");
    const int c = lane & 7;
#pragma unroll
    for (int j = 0; j < 4; ++j) { const int n = (lane >> 3) + 8 * j; const LAS float* s = scr + (8 * c) * 33 + n;
        v4u o; o.x = pk2(s[0 * 33], s[1 * 33]); o.y = pk2(s[2 * 33], s[3 * 33]); o.z = pk2(s[4 * 33], s[5 * 33]); o.w = pk2(s[6 * 33], s[7 * 33]);
        *(GAS v4u*)(WT + (size_t)(n0 + n) * K + k0 + 8 * c) = o; }
    LDS_WAIT(); asm volatile("" ::: "memory");
}
struct Args { const float* in[13]; float* out; unsigned char* ws; int ph_lo, ph_hi, li, pad; };

__device__ __forceinline__ void p0_prologue(Frame& F, const Args& A) {
    unsigned char* ws = A.ws;
    LAS float* scr = (LAS float*)(F.lds + RING_OFF + F.wave * 16384);
    const int gw = F.vcu * NWAVES + F.wave, NGW = F.G * NWAVES;
    constexpr int I_IN = (DM / 64) * (DIN / 32), I_OUT = (DM / 64) * (DM / 32), I_GATE = I_OUT, I_PLE = (DPLE / 64) * (DM / 32), PL = I_IN + I_OUT + I_GATE + I_PLE;
    for (int it = gw; it < NL * PL; it += NGW) {
        const int L = it / PL; int r = it % PL;
        if (r < I_IN) { p0_transpose_item(A.in[3] + (size_t)L * DM * DIN, DM, DIN, (bf16*)(ws + WS_WIN + L * WIN_BYTES), scr, r, F.lane); continue; } r -= I_IN;
        if (r < I_OUT) { p0_transpose_item(A.in[4] + (size_t)L * DM * DM, DM, DM, (bf16*)(ws + WS_WOUT + L * 2 * MiB), scr, r, F.lane); continue; } r -= I_OUT;
        if (r < I_GATE) { p0_transpose_item(A.in[11] + (size_t)L * DM * DM, DM, DM, (bf16*)(ws + WS_WGATE + L * 2 * MiB), scr, r, F.lane); continue; } r -= I_GATE;
        p0_transpose_item(A.in[10] + (size_t)L * DPLE * DM, DPLE, DM, (bf16*)(ws + WS_WPLE + L * 512 * KiB), scr, r, F.lane);
    }
    const int gt = gw * 64 + F.lane, NT = NGW * 64;
    { const float* sw = A.in[8]; bf16* dst = (bf16*)(ws + WS_SGUW);
      for (int i = gt; i < NL * 4 * 128 * 128; i += NT) { const int t = (i >> 7) & 127, s = i & 127; dst[i] = (bf16)f2bf(s <= t ? sw[i] : 0.f); } }
    { const float* pw = A.in[6]; bf16* dst = (bf16*)(ws + WS_POOLWT);
      for (int i = gt; i < NL * 4 * 64 * 64; i += NT) { const int lg = i >> 12, d = (i >> 6) & 63, c = i & 63; dst[i] = (bf16)f2bf(pw[(size_t)lg * 4096 + c * 64 + d]); } }
    { const float* rb = A.in[5]; float* dst = (float*)(ws + WS_BIAS2);
      for (int i = gt; i < NH * NBIAS; i += NT) { const int h = i / NBIAS, n = i % NBIAS; dst[i] = rb[t5_bucket(n) * NH + h] * LOG2E; } }
    { const GAS f32x4* p4 = (const GAS f32x4*)A.in[1]; GAS v4u* dst = (GAS v4u*)(ws + WS_PB);
      for (int i = gt; i < NL * M * DPLE / 8; i += NT) { const f32x4 a = p4[2 * (size_t)i], b = p4[2 * (size_t)i + 1]; v4u o; o.x = pk2(a.x, a.y); o.y = pk2(a.z, a.w); o.z = pk2(b.x, b.y); o.w = pk2(b.z, b.w); dst[i] = o; } }
    { const float* x = A.in[0]; const float* g0 = A.in[2]; bf16* xn = (bf16*)(ws + WS_XN); float* ssq = (float*)(ws + WS_SSQ);
      f32x4 gq[4];
#pragma unroll
      for (int j = 0; j < 4; ++j) gq[j] = ((const GAS f32x4*)g0)[F.lane + 64 * j];
      for (int m = gw; m < M; m += NGW) {
          const GAS f32x4* xr = (const GAS f32x4*)(x + (size_t)m * DM) + F.lane; GAS unsigned long long* o8 = (GAS unsigned long long*)(xn + (size_t)m * DM) + F.lane;
          float s = 0.f;
#pragma unroll
          for (int j = 0; j < 4; ++j) { const f32x4 v = xr[64 * j]; s += (v.x * v.x + v.y * v.y) + (v.z * v.z + v.w * v.w); const f32x4 w = v * gq[j];
              o8[64 * j] = (unsigned long long)pk2(w.x, w.y) | ((unsigned long long)pk2(w.z, w.w) << 32); }
          s = wave_sum(s);
          if (F.lane == 0) *(GAS f32x4*)(ssq + (size_t)m * 4) = (f32x4){s, 0.f, 0.f, 0.f};
      } }
}
__device__ __forceinline__ void final_norm(Frame& F, const Args& A) {
    const int gw = F.vcu * NWAVES + F.wave, NGW = F.G * NWAVES;
    const float* ssq = (const float*)(A.ws + WS_SSQ); const float* fg = A.in[12];
    f32x4 gq[4];
#pragma unroll
    for (int j = 0; j < 4; ++j) gq[j] = ((const GAS f32x4*)fg)[F.lane + 64 * j];
    for (int m = gw; m < M; m += NGW) {
        const f32x4 s4 = *(const GAS f32x4*)(ssq + (size_t)m * 4);
        const float rs = 1.0f / sqrtf(((s4.x + s4.y) + (s4.z + s4.w)) * (1.0f / 1024.0f) + 1e-6f);
        GAS f32x4* xr = (GAS f32x4*)(A.out + (size_t)m * DM) + F.lane;
#pragma unroll
        for (int j = 0; j < 4; ++j) { const f32x4 v = xr[64 * j]; xr[64 * j] = v * rs * gq[j]; }
    }
}

constexpr int N_PHASES = 14;
#define IN(k) (lo <= (k) && (k) < hi)
#define SEAM(k) do { if (IN(k) && IN((k) + 1)) xcd_barrier(bar); } while (0)
template <int L> __device__ __forceinline__ void layer_phases(Frame& F, const Args& args, const XcdBarrier& bar, const int lo, const int hi) {
    unsigned char* ws = args.ws;
    constexpr int P = 1 + 6 * L;
    if (IN(P + 0)) {
        pg8::Gemm g{(const bf16*)(ws + WS_XN), (const bf16*)(ws + WS_WIN + L * WIN_BYTES), M, DIN, DM}; pg8::StaticOrder S; S.init(M, DIN, F.G, (int)blockIdx.x);
        pg8::EpiZ E{(bf16*)(ws + WS_Z), (const float*)(ws + WS_SSQ), (float*)(ws + WS_CTL + CTL_KSUM) + (size_t)L * 64 * 512, C2, DIN};
        pg8::gemm_phase<pg8::EpiZ, pg8::StaticOrder, PG8_ALIGN, PG8_SP2>(F.lds + RING_OFF, g, S, E);
    }
    SEAM(P + 0);
    SEAM(P + 1); SEAM(P + 2); SEAM(P + 3);
    if (IN(P + 4)) {
        pg8::Gemm g{(const bf16*)(ws + WS_XN), (const bf16*)(ws + WS_WOUT + L * 2 * MiB), M, DM, DM}; pg8::StaticOrder S; S.init(M, DM, F.G, (int)blockIdx.x);
        pg8::EpiRes E{L == 0 ? args.in[0] : args.out, args.out, (bf16*)(ws + WS_H1B)};
        pg8::gemm_phase<pg8::EpiRes, pg8::StaticOrder, PG8_ALIGN, PG8_SP2>(F.lds + RING_OFF, g, S, E);
    }
    SEAM(P + 4);
    if (IN(P + 5)) {
        { pg8::Gemm g{(const bf16*)(ws + WS_H1B), (const bf16*)(ws + WS_WGATE + L * 2 * MiB), M, DM, DM}; pg8::StaticOrder S; S.init(M, DM, F.G, (int)blockIdx.x);
          pg8::EpiSig E{(bf16*)(ws + WS_TB)};
          pg8::gemm_phase<pg8::EpiSig, pg8::StaticOrder, PG8_ALIGN, PG8_SP2>(F.lds + RING_OFF, g, S, E); }
        { pg8::Gemm g{(const bf16*)(ws + WS_PB) + (size_t)L * M * DPLE, (const bf16*)(ws + WS_WPLE + L * 512 * KiB), M, DM, DPLE}; pg8::StaticOrder S; S.init(M, DM, F.G, (int)blockIdx.x);
          pg8::EpiPle E{(const bf16*)(ws + WS_TB), args.out, (bf16*)(ws + WS_XN), L + 1 < NL ? args.in[2] + (size_t)(L + 1) * DM : args.in[12], (float*)(ws + WS_SSQ)};
          pg8::gemm_phase<pg8::EpiPle, pg8::StaticOrder, false, PG8_SP2>(F.lds + RING_OFF, g, S, E); }
    }
    SEAM(P + 5);
}
__global__ void __launch_bounds__(NWAVES * 64, 2) skel_fwd(Args args) {
    extern __shared__ __attribute__((aligned(16))) unsigned char lds[];
    Frame F;
    F.lds = (LAS unsigned char*)lds;
    F.MISC = (volatile LAS unsigned*)(F.lds + MISC_OFF);
    F.tid = threadIdx.x; F.lane = F.tid & 63; F.wave = __builtin_amdgcn_readfirstlane(F.tid >> 6);
    F.G = gridDim.x; { const int bx = blockIdx.x; F.vcu = (F.G % 8 == 0) ? (bx % 8) * (F.G / 8) + bx / 8 : bx; }
    F.ctl = (gu32*)(args.ws + WS_CTL);
    for (int u = F.tid; u < (LDS_BYTES - LDSCTL_OFF) / 4; u += NWAVES * 64) ((LAS unsigned*)(F.lds + LDSCTL_OFF))[u] = 0u;
    __syncthreads();
    XcdBarrier bar = xcd_barrier_post((unsigned*)(F.ctl + CW_BAR) + args.li * XCD_BAR_WORDS, F.MISC + 8);
    const int lo = args.ph_lo, hi = args.ph_hi;
    if (IN(0)) p0_prologue(F, args);
    SEAM(0);
    layer_phases<0>(F, args, bar, lo, hi);
    layer_phases<1>(F, args, bar, lo, hi);
    if (IN(N_PHASES - 1)) final_norm(F, args);
}
__global__ void __launch_bounds__(256) naive_attn(const bf16* __restrict__ Z, const float* __restrict__ ksum, const float* __restrict__ bias2, bf16* Y) {
    const int idx = blockIdx.x * 256 + threadIdx.x;
    const int m = idx >> 3, h = idx & 7, b = m >> 13, t = m & 8191, own = t >> 8;
    float q[64];
    { const v4u* qp = (const v4u*)(Z + (size_t)m * DIN + ZQ + h * 64);
#pragma unroll
      for (int c = 0; c < 8; ++c) { const v4u w = qp[c]; q[8 * c + 0] = __uint_as_float(w.x << 16); q[8 * c + 1] = __uint_as_float(w.x & 0xffff0000u); q[8 * c + 2] = __uint_as_float(w.y << 16); q[8 * c + 3] = __uint_as_float(w.y & 0xffff0000u);
          q[8 * c + 4] = __uint_as_float(w.z << 16); q[8 * c + 5] = __uint_as_float(w.z & 0xffff0000u); q[8 * c + 6] = __uint_as_float(w.w << 16); q[8 * c + 7] = __uint_as_float(w.w & 0xffff0000u); } }
    float g0 = -INFINITY, g1 = -INFINITY, g2 = -INFINITY; int j0 = -1, j1 = -1, j2 = -1;
    for (int j = 0; j < own; ++j) {
        const float* ks = ksum + (size_t)(b * 32 + j) * 512 + h * 64; float g = 0.f;
#pragma unroll
        for (int d = 0; d < 64; ++d) g += q[d] * ks[d];
        if (g > g0) { g2 = g1; j2 = j1; g1 = g0; j1 = j0; g0 = g; j0 = j; }
        else if (g > g1) { g2 = g1; j2 = j1; g1 = g; j1 = j; }
        else if (g > g2) { g2 = g; j2 = j; }
    }
    float mrun = -INFINITY, l = 0.f, o[64];
#pragma unroll
    for (int d = 0; d < 64; ++d) o[d] = 0.f;
    for (int s = 0; s < 4; ++s) {
        const int jb = s == 0 ? j0 : s == 1 ? j1 : s == 2 ? j2 : own;
        if (jb < 0) continue;
        const int kend = (jb == own) ? (t & 255) : 255;
        for (int kk = 0; kk <= kend; ++kk) {
            const int tk = jb * 256 + kk;
            const bf16* kr = Z + (size_t)(b * SEQ + tk) * DIN + ZK + h * 64; const bf16* vr = kr + (ZV - ZK);
            float sc = 0.f;
#pragma unroll
            for (int c = 0; c < 8; ++c) { const v4u w = ((const v4u*)kr)[c];
                sc += q[8 * c + 0] * __uint_as_float(w.x << 16) + q[8 * c + 1] * __uint_as_float(w.x & 0xffff0000u) + q[8 * c + 2] * __uint_as_float(w.y << 16) + q[8 * c + 3] * __uint_as_float(w.y & 0xffff0000u)
                    + q[8 * c + 4] * __uint_as_float(w.z << 16) + q[8 * c + 5] * __uint_as_float(w.z & 0xffff0000u) + q[8 * c + 6] * __uint_as_float(w.w << 16) + q[8 * c + 7] * __uint_as_float(w.w & 0xffff0000u); }
            const int dist = t - tk; sc += bias2[h * NBIAS + (dist < 128 ? dist : 128)];
            if (sc > mrun) { const float f = exp2f(mrun - sc); l *= f;
#pragma unroll
                for (int d = 0; d < 64; ++d) o[d] *= f;
                mrun = sc; }
            const float p = exp2f(sc - mrun); l += p;
#pragma unroll
            for (int c = 0; c < 8; ++c) { const v4u w = ((const v4u*)vr)[c];
                o[8 * c + 0] += p * __uint_as_float(w.x << 16); o[8 * c + 1] += p * __uint_as_float(w.x & 0xffff0000u); o[8 * c + 2] += p * __uint_as_float(w.y << 16); o[8 * c + 3] += p * __uint_as_float(w.y & 0xffff0000u);
                o[8 * c + 4] += p * __uint_as_float(w.z << 16); o[8 * c + 5] += p * __uint_as_float(w.z & 0xffff0000u); o[8 * c + 6] += p * __uint_as_float(w.w << 16); o[8 * c + 7] += p * __uint_as_float(w.w & 0xffff0000u); }
        }
    }
    const float rl = 1.f / l;
    const bf16* ga = Z + (size_t)m * DIN + ZGA + h * 64; bf16* y = Y + (size_t)m * DM + h * 64;
#pragma unroll
    for (int d = 0; d < 64; d += 2) { const unsigned gw = *(const unsigned*)(ga + d); const float a0 = o[d] * rl * silu_f(__uint_as_float(gw << 16)), a1 = o[d + 1] * rl * silu_f(__uint_as_float(gw & 0xffff0000u)); *(unsigned*)(y + d) = pk2(a0, a1); }
}
__global__ void __launch_bounds__(256) naive_pool(const bf16* __restrict__ Z, const float* __restrict__ pw, const float* __restrict__ pscale, bf16* Y) {
    const int idx = blockIdx.x * 256 + threadIdx.x;
    const int m = idx >> 2, gi = idx & 3, w = 2 << gi, t = m & 8191;
    float pooled[64];
#pragma unroll
    for (int c = 0; c < 64; ++c) pooled[c] = 0.f;
    const int n = (t + 1 < w) ? t + 1 : w;
    for (int s = 0; s < n; ++s) { const bf16* xr = Z + (size_t)(m - s) * DIN + ZXB + gi * 64;
#pragma unroll
        for (int c = 0; c < 64; ++c) pooled[c] += bf2f(xr[c]); }
    { const bf16* xr = Z + (size_t)m * DIN + ZXB + gi * 64; const float inv = 1.f / (float)n;
#pragma unroll
      for (int c = 0; c < 64; ++c) pooled[c] = pooled[c] * inv - bf2f(xr[c]); }
    const bf16* gb = Z + (size_t)m * DIN + ZGB + gi * 64; bf16* y = Y + (size_t)m * DM + 512 + gi * 64;
    for (int d = 0; d < 64; ++d) { float a = 0.f;
#pragma unroll
        for (int c = 0; c < 64; ++c) a += pooled[c] * pw[(size_t)(gi * 64 + c) * 64 + d];
        y[d] = (bf16)f2bf(a * pscale[gi * 64 + d] * silu_f(bf2f(gb[d]))); }
}
__global__ void __launch_bounds__(256) naive_sgu_stats(const bf16* __restrict__ Z, float* stats) {
    const int m = blockIdx.x * 256 + threadIdx.x; const bf16* v = Z + (size_t)m * DIN + ZVC;
    float s = 0.f; for (int c = 0; c < 256; ++c) s += bf2f(v[c]);
    const float mu = s * (1.f / 256.f); float q = 0.f; for (int c = 0; c < 256; ++c) { const float d = bf2f(v[c]) - mu; q += d * d; }
    stats[2 * m] = mu; stats[2 * m + 1] = 1.0f / sqrtf(q * (1.f / 256.f) + 1e-6f);
}
__global__ void __launch_bounds__(256) naive_sgu(const bf16* __restrict__ Z, const float* __restrict__ stats, const float* __restrict__ sw, const float* __restrict__ sb, bf16* Y) {
    const int idx = blockIdx.x * 256 + threadIdx.x;
    const int m = idx >> 8, c = idx & 255, hh = c >> 6, t = m & 127, m0 = m - t;
    float a = 0.f;
    for (int s = 0; s <= t; ++s) a += sw[(size_t)(hh * 128 + t) * 128 + s] * (bf2f(Z[(size_t)(m0 + s) * DIN + ZVC + c]) - stats[2 * (m0 + s)]) * stats[2 * (m0 + s) + 1];
    a += sb[hh * 128 + t];
    Y[(size_t)m * DM + 768 + c] = (bf16)f2bf(bf2f(Z[(size_t)m * DIN + ZUC + c]) * a * silu_f(bf2f(Z[(size_t)m * DIN + ZGC + c])));
}

extern "C" void kernel_launch(void* const* d_in, const int* in_sizes, int n_in, void* d_out, int out_size, void* d_ws, size_t ws_size, hipStream_t stream) {
    static int grid = 0;
    if (grid == 0) {
        if (n_in != 13 || in_sizes[0] != M * DM || out_size != M * DM || ws_size < WS_END) { fprintf(stderr, "kernel_launch: unexpected shapes: n_in %d in0 %d out %d ws %zu (need %zu)\n", n_in, n_in > 0 ? in_sizes[0] : -1, out_size, ws_size, (size_t)WS_END); grid = -1; return; }
        int dev = 0, cus = 0, per_cu = 0;
        if (hipGetDevice(&dev) != hipSuccess || hipDeviceGetAttribute(&cus, hipDeviceAttributeMultiprocessorCount, dev) != hipSuccess) { grid = -1; return; }
        if (hipFuncSetAttribute((const void*)skel_fwd, hipFuncAttributeMaxDynamicSharedMemorySize, LDS_BYTES) != hipSuccess) { fprintf(stderr, "kernel_launch: hipFuncSetAttribute failed\n"); grid = -1; return; }
        if (hipOccupancyMaxActiveBlocksPerMultiprocessor(&per_cu, (const void*)skel_fwd, NWAVES * 64, LDS_BYTES) != hipSuccess || per_cu < 1) fprintf(stderr, "kernel_launch: occupancy query reports %d\n", per_cu);
        (void)hipGetLastError();
        grid = cus;
        if (grid != 256) fprintf(stderr, "kernel_launch: %d CUs; this kernel needs 256\n", grid);
    }
    if (grid < 0) return;
    hipMemsetAsync((char*)d_ws + WS_CTL, 0, CTL_ZERO_BYTES, stream);
    Args a{};
    for (int i = 0; i < 13; ++i) a.in[i] = (const float*)d_in[i];
    a.out = (float*)d_out; a.ws = (unsigned char*)d_ws;
    unsigned char* ws = (unsigned char*)d_ws;
    const int cuts[4] = {0, 2, 8, 14}; int li = 0;
    for (int seg = 0; seg < 3; ++seg) {
        a.ph_lo = seg == 0 ? 0 : (seg == 1 ? 5 : 11); a.ph_hi = cuts[seg + 1]; a.li = li++;
        hipLaunchKernelGGL(skel_fwd, dim3(grid), dim3(NWAVES * 64), LDS_BYTES, stream, a);
        if (seg < 2) {
            const int L = seg;
            const bf16* Z = (const bf16*)(ws + WS_Z); bf16* Y = (bf16*)(ws + WS_XN);
            hipLaunchKernelGGL(naive_attn, dim3(M * NH / 256), dim3(256), 0, stream, Z, (const float*)(ws + WS_CTL + CTL_KSUM) + (size_t)L * 64 * 512, (const float*)(ws + WS_BIAS2), Y);
            hipLaunchKernelGGL(naive_pool, dim3(M * 4 / 256), dim3(256), 0, stream, Z, (const float*)d_in[6] + (size_t)L * 4 * 64 * 64, (const float*)d_in[7] + (size_t)L * 256, Y);
            hipLaunchKernelGGL(naive_sgu_stats, dim3(M / 256), dim3(256), 0, stream, Z, (float*)(ws + WS_STATS));
            hipLaunchKernelGGL(naive_sgu, dim3(M * 256 / 256), dim3(256), 0, stream, Z, (const float*)(ws + WS_STATS), (const float*)d_in[8] + (size_t)L * 4 * 128 * 128, (const float*)d_in[9] + (size_t)L * 4 * 128, Y);
        }
    }
}
```

```cpp
#include <hip/hip_runtime.h>
#include <cstdio>
#include <cstdint>
namespace pg8 {
#define PG8_LAS __attribute__((address_space(3)))
typedef unsigned short bf16_t;
typedef short bf16x8 __attribute__((ext_vector_type(8)));
typedef float f32x4 __attribute__((ext_vector_type(4)));
typedef unsigned u32x4 __attribute__((ext_vector_type(4)));
constexpr int BM = 256, BK = 64, HALF = 128, HTB = HALF * BK * 2  , STAGE_BYTES = 8 * HTB, NXCD = 8, WGM = 8;

__host__ __device__ __forceinline__ int lds_byte(int r, int c) { const int st = (r >> 4) * 2 + (c >> 5), rr = r & 15, cc = c & 31, ob = rr * 64 + cc * 2; return st * 1024 + (ob ^ (((ob >> 9) & 1) << 5)); }
__host__ __device__ __forceinline__ void stage_rc(int b, int& R, int& C) { const int st = b / 1024, sb = b % 1024, swz = sb ^ (((sb >> 9) & 1) << 5); R = (st >> 1) * 16 + swz / 64; C = (st & 1) * 32 + (swz % 64) / 2; }
__host__ __device__ __forceinline__ int perm32(int rho) { const int n = rho >> 4, i = rho & 15; return 8 * (i >> 2) + 4 * n + (i & 3); }

struct Unit { int pm, pn; };
struct UnitX { int pm, pn, kind, nt, ldsel; const char* A; const char* B; };
struct Gemm { const bf16_t* A; const bf16_t* Bt; int M, N, K, ld; };

struct StaticOrder {
    int nM, nN, nwg, G, c;
    __host__ __device__ void init(int M, int N, int G_, int c_) { nM = M / BM; nN = N / BM; nwg = nM * nN; G = G_; c = c_; }
    __host__ __device__ bool next(int i, Unit& u) const {
        const long L = (long)i * G + c; if (L >= nwg) return false;
        int wgid = (int)L; { const int q = nwg / NXCD, r = nwg % NXCD, xcd = wgid % NXCD, off = wgid / NXCD; wgid = (xcd < r ? xcd * (q + 1) : r * (q + 1) + (xcd - r) * q) + off; }
        const int nig = WGM * nN, gid = wgid / nig, fm = gid * WGM, gsz = (nM - fm) < WGM ? (nM - fm) : WGM;
        u.pm = fm + ((wgid % nig) % gsz); u.pn = (wgid % nig) / gsz; return true;
    }
    __device__ __forceinline__ void a_ready(const Unit&) const {}
    __device__ __forceinline__ void done(const Unit&) const {}
};

typedef float f32x2_t __attribute__((ext_vector_type(2))); typedef __bf16 bf16x2_t __attribute__((ext_vector_type(2)));
__device__ __forceinline__ unsigned cvt_pk_bf16(float lo, float hi) { f32x2_t v = {lo, hi}; bf16x2_t b = __builtin_convertvector(v, bf16x2_t); return __builtin_bit_cast(unsigned, b); }
__device__ __forceinline__ float bf_lo(unsigned w) { return __uint_as_float(w << 16); }
__device__ __forceinline__ float bf_hi(unsigned w) { return __uint_as_float(w & 0xffff0000u); }
typedef unsigned u32x2 __attribute__((ext_vector_type(2)));

struct EpiZ {
    static constexpr bool PERM = true, AFTER_DRAIN = false;
    bf16_t* Z; const float* ssq; float* ksum; float qscale; int ldz; float* vstat;
    __device__ __forceinline__ void operator()(const f32x4 (&acc)[2][2][4][2], const Unit& u, int wr, int wc, int fr, int fq) const {
        const int row0 = u.pm * BM + wr * 64 + fr, col0 = u.pn * BM + wc * 32 + 8 * fq;
        const float sc = (u.pn < 2) ? qscale : 1.f;
        const bool ktile = (u.pn == 2 || u.pn == 3), vtile = (u.pn == 11);
        float cs[2][8];
#pragma unroll
        for (int bj = 0; bj < 2; ++bj)
#pragma unroll
            for (int i = 0; i < 8; ++i) cs[bj][i] = 0.f;
#pragma unroll
        for (int ai = 0; ai < 2; ++ai)
#pragma unroll
            for (int m = 0; m < 4; ++m) {
                const int row = row0 + ai * HALF + m * 16;
                const f32x4 s4 = *(const f32x4*)(ssq + (size_t)row * 4);
                const float rs = __builtin_amdgcn_rsqf(((s4[0] + s4[1]) + (s4[2] + s4[3])) * (1.0f / 1024.0f) + 1e-6f) * sc;
                bf16_t* rowp = Z + (size_t)row * ldz + col0;
                float vs = 0.f, vq = 0.f;
#pragma unroll
                for (int bj = 0; bj < 2; ++bj) {
                    const f32x4 v0 = acc[ai][bj][m][0] * rs, v1 = acc[ai][bj][m][1] * rs;
                    if (vtile) { vs += (v0[0] + v0[1]) + (v0[2] + v0[3]) + (v1[0] + v1[1]) + (v1[2] + v1[3]);
                                 vq += (v0[0] * v0[0] + v0[1] * v0[1]) + (v0[2] * v0[2] + v0[3] * v0[3]) + (v1[0] * v1[0] + v1[1] * v1[1]) + (v1[2] * v1[2] + v1[3] * v1[3]); }
                    u32x4 w; w.x = cvt_pk_bf16(v0[0], v0[1]); w.y = cvt_pk_bf16(v0[2], v0[3]); w.z = cvt_pk_bf16(v1[0], v1[1]); w.w = cvt_pk_bf16(v1[2], v1[3]);
                    *(u32x4*)(rowp + bj * HALF) = w;
                    if (ktile) {
#pragma unroll
                        for (int i = 0; i < 4; ++i) { cs[bj][i] += v0[i]; cs[bj][4 + i] += v1[i]; }
                    }
                }
                if (vtile) { vs += __shfl_xor(vs, 16); vs += __shfl_xor(vs, 32); vq += __shfl_xor(vq, 16); vq += __shfl_xor(vq, 32);
                             if (fq == 0) { typedef float f2_ __attribute__((ext_vector_type(2))); *(f2_*)(vstat + ((size_t)row * 4 + wc) * 2) = (f2_){vs, vq}; } }
            }
        if (ktile) {
#pragma unroll
            for (int bj = 0; bj < 2; ++bj)
#pragma unroll
                for (int i = 0; i < 8; ++i) {
                    float v = cs[bj][i];
                    v += __shfl_xor(v, 1); v += __shfl_xor(v, 2); v += __shfl_xor(v, 4); v += __shfl_xor(v, 8);
                    if (fr == 0) atomicAdd(ksum + (size_t)u.pm * 512 + (u.pn - 2) * 256 + bj * HALF + wc * 32 + 8 * fq + i, v);
                }
        }
    }
};
template <bool BASE_F32> struct EpiRes {
    static constexpr bool PERM = true, AFTER_DRAIN = false;
    const void* base; bf16_t* hb;
    __device__ __forceinline__ void operator()(const f32x4 (&acc)[2][2][4][2], const Unit& u, int wr, int wc, int fr, int fq) const {
        const int row0 = u.pm * BM + wr * 64 + fr, col0 = u.pn * BM + wc * 32 + 8 * fq;
#pragma unroll
        for (int ai = 0; ai < 2; ++ai)
#pragma unroll
            for (int m = 0; m < 4; ++m) {
                const size_t off = (size_t)(row0 + ai * HALF + m * 16) * 1024 + col0;
#pragma unroll
                for (int bj = 0; bj < 2; ++bj) {
                    f32x4 b0, b1;
                    if (BASE_F32) { b0 = *(const f32x4*)((const float*)base + off + bj * HALF); b1 = *(const f32x4*)((const float*)base + off + bj * HALF + 4); }
                    else { const u32x4 w = *(const u32x4*)((const bf16_t*)base + off + bj * HALF); b0 = (f32x4){bf_lo(w.x), bf_hi(w.x), bf_lo(w.y), bf_hi(w.y)}; b1 = (f32x4){bf_lo(w.z), bf_hi(w.z), bf_lo(w.w), bf_hi(w.w)}; }
                    const f32x4 o0 = b0 + acc[ai][bj][m][0], o1 = b1 + acc[ai][bj][m][1];
                    u32x4 w; w.x = cvt_pk_bf16(o0[0], o0[1]); w.y = cvt_pk_bf16(o0[2], o0[3]); w.z = cvt_pk_bf16(o1[0], o1[1]); w.w = cvt_pk_bf16(o1[2], o1[3]);
                    *(u32x4*)(hb + off + bj * HALF) = w;
                }
            }
    }
};
struct EpiT {
    static constexpr bool PERM = true, AFTER_DRAIN = false;
    bf16_t* T;
    __device__ __forceinline__ void operator()(const f32x4 (&acc)[2][2][4][2], const Unit& u, int wr, int wc, int fr, int fq) const {
        const int row0 = u.pm * BM + wr * 64 + fr, col0 = u.pn * BM + wc * 32 + 8 * fq;
#pragma unroll
        for (int ai = 0; ai < 2; ++ai)
#pragma unroll
            for (int m = 0; m < 4; ++m) {
                bf16_t* rowp = T + (size_t)(row0 + ai * HALF + m * 16) * 1024 + col0;
#pragma unroll
                for (int bj = 0; bj < 2; ++bj) {
                    const f32x4 v0 = acc[ai][bj][m][0], v1 = acc[ai][bj][m][1];
                    u32x4 w; w.x = cvt_pk_bf16(v0[0], v0[1]); w.y = cvt_pk_bf16(v0[2], v0[3]); w.z = cvt_pk_bf16(v1[0], v1[1]); w.w = cvt_pk_bf16(v1[2], v1[3]);
                    *(u32x4*)(rowp + bj * HALF) = w;
                }
            }
    }
};
struct EpiPart {
    static constexpr bool PERM = true, AFTER_DRAIN = false;
    float* out; int rows;
    __device__ __forceinline__ void operator()(const f32x4 (&acc)[2][2][4][2], const Unit& u, int wr, int wc, int fr, int fq) const {
        const int col0 = wc * 32 + 8 * fq; float* base = out + (size_t)u.pn * rows * 256;
#pragma unroll
        for (int ai = 0; ai < 2; ++ai)
#pragma unroll
            for (int m = 0; m < 4; ++m) {
                float* rowp = base + (size_t)(u.pm * BM + ai * HALF + wr * 64 + m * 16 + fr) * 256 + col0;
#pragma unroll
                for (int bj = 0; bj < 2; ++bj) { *(f32x4*)(rowp + bj * HALF) = acc[ai][bj][m][0]; *(f32x4*)(rowp + bj * HALF + 4) = acc[ai][bj][m][1]; }
            }
    }
};
struct OneUnit {
    int pm, pn; bool has;
    __device__ __forceinline__ bool next(int i, Unit& u) const { if (i > 0 || !has) return false; u.pm = pm; u.pn = pn; return true; }
    __device__ __forceinline__ void a_ready(const Unit&) const {}
    __device__ __forceinline__ void done(const Unit&) const {}
};
struct IdleOrder {
    int G, c;
    __device__ __forceinline__ bool next(int i, Unit& u) const { const int h = G / 2; if (c < h) return false; const int L = i * h + (c - h); if (L >= 256) return false; u.pm = L >> 2; u.pn = L & 3; return true; }
    __device__ __forceinline__ void a_ready(const Unit&) const {}
    __device__ __forceinline__ void done(const Unit&) const {}
};
struct EpiP1 {
    static constexpr bool PERM = true, AFTER_DRAIN = false;
    EpiZ z; EpiPart h; EpiT t;
    __device__ __forceinline__ void operator()(const f32x4 (&acc)[2][2][4][2], const UnitX& u, int wr, int wc, int fr, int fq) const {
        const Unit uu{u.pm, u.pn};
        if (u.kind == 0) z(acc, uu, wr, wc, fr, fq); else if (u.kind == 1) h(acc, uu, wr, wc, fr, fq); else t(acc, uu, wr, wc, fr, fq);
    }
};
struct SchedP1 {
    StaticOrder so; const char* Ain; const char* Wt; const char* Pb; const char* Wp; int G, c;
    __device__ __forceinline__ bool next(int i, UnitX& u) const {
        constexpr size_t TS = (size_t)256 * 1024 * 2, TQ = (size_t)256 * 256 * 2;
        const int hG = G / 2; int mi = -1, xi = -1;
        if (c < hG) { const int xp = ((c >> 1) & 1) ? 2 : 0;
            if (i == xp) xi = 0; else mi = i < xp ? i : i - 1; }
        else { const int x0 = (c & 1) ? 0 : 1, x1 = (c & 1) ? 2 : 3;
            if (i == x0) xi = 0; else if (i == x1) xi = 1; else mi = i - (i > x0 ? 1 : 0) - (i > x1 ? 1 : 0); }
        if (mi >= 0) { if (mi > 2) return false; Unit q; if (!so.next(mi, q)) return false; u.pm = q.pm; u.pn = q.pn; u.kind = 0; u.nt = 16; u.ldsel = 0; u.A = Ain + q.pm * TS; u.B = Wt + q.pn * TS; return true; }
        if (c < hG) { const int pm = c >> 1, kh = c & 1;
            u.pm = pm; u.pn = kh; u.kind = 1; u.nt = 8; u.ldsel = 0; u.A = Ain + pm * TS + kh * 1024; u.B = Wt + 12 * TS + kh * 1024; return true; }
        const int L = xi * hG + (c - hG); if (L >= 256) return false;
        u.pm = L >> 2; u.pn = L & 3; u.kind = 2; u.nt = 4; u.ldsel = 1; u.A = Pb + (L >> 2) * TQ; u.B = Wp + (L & 3) * TQ; return true;
    }
};
struct EpiPle {
    static constexpr bool PERM = true, AFTER_DRAIN = true;
    const bf16_t* T; const bf16_t* h1; bf16_t* xs; float* ssq;
    __device__ __forceinline__ void fused(f32x4 (&acc)[2][2][4][2], const Unit& u, int wr, int wc, int fr, int fq, PG8_LAS unsigned char* lds, int wid, int lane) const {
        PG8_LAS float* P = (PG8_LAS float*)lds;
        const int col0 = u.pn * BM + wc * 32 + 8 * fq;
#pragma unroll
        for (int ai = 0; ai < 2; ++ai)
#pragma unroll
            for (int m = 0; m < 4; ++m) {
                const int rl = ai * HALF + wr * 64 + m * 16 + fr;
                const size_t off = (size_t)(u.pm * BM + rl) * 1024 + col0;
                float q = 0.f;
#pragma unroll
                for (int bj = 0; bj < 2; ++bj) {
                    const u32x4 tw = *(const u32x4*)(T + off + bj * HALF), hw = *(const u32x4*)(h1 + off + bj * HALF);
                    const f32x4 t0 = (f32x4){bf_lo(tw.x), bf_hi(tw.x), bf_lo(tw.y), bf_hi(tw.y)}, t1 = (f32x4){bf_lo(tw.z), bf_hi(tw.z), bf_lo(tw.w), bf_hi(tw.w)};
                    const f32x4 h0 = (f32x4){bf_lo(hw.x), bf_hi(hw.x), bf_lo(hw.y), bf_hi(hw.y)}, h1v = (f32x4){bf_lo(hw.z), bf_hi(hw.z), bf_lo(hw.w), bf_hi(hw.w)};
                    f32x4 s0 = acc[ai][bj][m][0], s1 = acc[ai][bj][m][1];
#pragma unroll
                    for (int i = 0; i < 4; ++i) { s0[i] = __builtin_amdgcn_rcpf(1.f + __expf(-s0[i])); s1[i] = __builtin_amdgcn_rcpf(1.f + __expf(-s1[i])); }
                    const f32x4 o0 = h0 + t0 * s0, o1 = h1v + t1 * s1;
                    q += (o0[0] * o0[0] + o0[1] * o0[1]) + (o0[2] * o0[2] + o0[3] * o0[3]) + (o1[0] * o1[0] + o1[1] * o1[1]) + (o1[2] * o1[2] + o1[3] * o1[3]);
                    u32x4 w; w.x = cvt_pk_bf16(o0[0], o0[1]); w.y = cvt_pk_bf16(o0[2], o0[3]); w.z = cvt_pk_bf16(o1[0], o1[1]); w.w = cvt_pk_bf16(o1[2], o1[3]); *(u32x4*)(xs + off + bj * HALF) = w;
                }
                q += __shfl_xor(q, 16); q += __shfl_xor(q, 32);
                if (fq == 0) P[rl * 4 + wc] = q;
                asm volatile("" ::: "memory");
            }
        asm volatile("s_waitcnt lgkmcnt(0)" ::: "memory"); __builtin_amdgcn_s_barrier(); asm volatile("" ::: "memory");
        const int t = wid * 64 + lane;
        if (t < 256) { const float s = (P[t * 4 + 0] + P[t * 4 + 1]) + (P[t * 4 + 2] + P[t * 4 + 3]); ssq[(size_t)(u.pm * BM + t) * 4 + u.pn] = s; }
        asm volatile("s_waitcnt lgkmcnt(0)" ::: "memory"); __builtin_amdgcn_s_barrier(); asm volatile("" ::: "memory");
    }
};

template <class Epi, class Sched, bool ALIGN_EPI = false, bool SP2 = false>
__device__ __forceinline__ void gemm_phase(PG8_LAS unsigned char* lds, const Gemm g, const Sched& S, const Epi& E) {
    const int tid = threadIdx.x, wid = __builtin_amdgcn_readfirstlane(tid >> 6), lane = tid & 63, wr = wid >> 2, wc = wid & 3, fr = lane & 15, fq = lane >> 4;
    const int K = g.K, LD = g.ld, nt = K / BK;
    unsigned voffA[2], voffB[2];
#pragma unroll
    for (int i = 0; i < 2; ++i) { int R, C; stage_rc(tid * 16 + i * 8192, R, C); const int Rb = Epi::PERM ? ((R & ~31) + perm32(R & 31)) : R;
        voffA[i] = (unsigned)(R * LD + C) * 2u; voffB[i] = (unsigned)(Rb * LD + C) * 2u; }
    const size_t kstep = (size_t)(BK * 2);
    const size_t hstep = (size_t)HALF * LD * 2;
    const size_t tstep = 2 * hstep;
    const unsigned ldsw = (unsigned)wid * 1024u;
    const int aoff = lds_byte(wr * 64 + fr, fq * 8), boff = lds_byte(wc * 32 + fr, fq * 8);
#define PG8_SA(b, h) (((b) * 2 + (h)) * HTB)
#define PG8_SB(b, h) ((4 + (b) * 2 + (h)) * HTB)
#define PG8_STAGE(bufoff, gbase, voff) do { _Pragma("unroll") for (int _i = 0; _i < 2; ++_i) \
        __builtin_amdgcn_global_load_lds((const unsigned*)((const char*)(gbase) + (voff)[_i]), (PG8_LAS unsigned*)(lds + (bufoff) + ldsw + _i * 8192), 16, 0, 0); } while (0)
#define PG8_LDA(dst, b, h) do { _Pragma("unroll") for (int m = 0; m < 4; ++m) _Pragma("unroll") for (int k = 0; k < 2; ++k) dst[m][k] = *(const PG8_LAS bf16x8*)(lds + PG8_SA(b, h) + aoff + m * 2048 + k * 1024); } while (0)
#define PG8_LDB(dst, b, h) do { _Pragma("unroll") for (int n = 0; n < 2; ++n) _Pragma("unroll") for (int k = 0; k < 2; ++k) dst[n][k] = *(const PG8_LAS bf16x8*)(lds + PG8_SB(b, h) + boff + n * 2048 + k * 1024); } while (0)
#define PG8_MMA(ai, bj, At, Bt) do { __builtin_amdgcn_s_setprio(1); _Pragma("unroll") for (int m = 0; m < 4; ++m) _Pragma("unroll") for (int n = 0; n < 2; ++n) _Pragma("unroll") for (int k = 0; k < 2; ++k) \
        acc[ai][bj][m][n] = __builtin_amdgcn_mfma_f32_16x16x32_bf16(Bt[n][k], At[m][k], acc[ai][bj][m][n], 0, 0, 0); __builtin_amdgcn_s_setprio(0); } while (0)
#define PG8_WAIT_V(n) asm volatile("s_waitcnt vmcnt(" #n ")" ::: "memory")
#define PG8_WAIT_L(n) asm volatile("s_waitcnt lgkmcnt(" #n ")" ::: "memory")
#define PG8_BAR __builtin_amdgcn_s_barrier()
#define PG8_SCHED __builtin_amdgcn_sched_barrier(0)
    Unit cur, nxt; int ui = 0;
    if (!S.next(0, cur)) return;
    f32x4 acc[2][2][4][2];
#pragma unroll
    for (int a = 0; a < 2; ++a)
#pragma unroll
        for (int b = 0; b < 2; ++b)
#pragma unroll
            for (int m = 0; m < 4; ++m)
#pragma unroll
                for (int n = 0; n < 2; ++n) acc[a][b][m][n] = (f32x4){0.f, 0.f, 0.f, 0.f};
    bf16x8 At[4][2], B0[2][2], B1[2][2];
    const char* cA = (const char*)g.A + (size_t)cur.pm * tstep; const char* cB = (const char*)g.Bt + (size_t)cur.pn * tstep;
    S.a_ready(cur);
    if constexpr (SP2) {
        PG8_STAGE(PG8_SB(0, 0), cB, voffB); PG8_STAGE(PG8_SB(0, 1), cB + hstep, voffB); PG8_STAGE(PG8_SA(0, 0), cA, voffA); PG8_STAGE(PG8_SA(0, 1), cA + hstep, voffA);
        if (wr == 1) PG8_BAR;
        PG8_WAIT_V(2); PG8_BAR;
        PG8_STAGE(PG8_SB(1, 0), cB + kstep, voffB); PG8_STAGE(PG8_SA(1, 0), cA + kstep, voffA); PG8_STAGE(PG8_SB(1, 1), cB + hstep + kstep, voffB);
        PG8_WAIT_V(6); PG8_BAR;
    } else {
        PG8_STAGE(PG8_SB(0, 0), cB, voffB); PG8_STAGE(PG8_SA(0, 0), cA, voffA); PG8_STAGE(PG8_SB(0, 1), cB + hstep, voffB); PG8_STAGE(PG8_SA(0, 1), cA + hstep, voffA);
        if (wr == 1) PG8_BAR;
        PG8_WAIT_V(4); PG8_BAR;
        PG8_STAGE(PG8_SB(1, 0), cB + kstep, voffB); PG8_STAGE(PG8_SA(1, 0), cA + kstep, voffA); PG8_STAGE(PG8_SB(1, 1), cB + hstep + kstep, voffB);
        PG8_WAIT_V(6); PG8_BAR;
    }
    for (;;) {
        const bool has_next = S.next(ui + 1, nxt);
        const char* nA = has_next ? (const char*)g.A + (size_t)nxt.pm * tstep : cA; const char* nB = has_next ? (const char*)g.Bt + (size_t)nxt.pn * tstep : cB;
        for (int t = 0; t < nt; t += 2) {
            const bool last = (t == nt - 2);
            const char* a1 = cA + (size_t)(t + 1) * kstep;
            const char* a2 = last ? nA : cA + (size_t)(t + 2) * kstep; const char* b2 = last ? nB : cB + (size_t)(t + 2) * kstep;
            const char* a3 = a2 + kstep; const char* b3 = b2 + kstep;
            if (last && has_next) S.a_ready(nxt);
            if constexpr (SP2) {
            PG8_LDB(B0, 0, 0); PG8_LDB(B1, 0, 1); PG8_SCHED; PG8_LDA(At, 0, 0); PG8_STAGE(PG8_SA(1, 1), a1 + hstep, voffA);
            PG8_WAIT_V(8); PG8_WAIT_L(0); PG8_BAR; PG8_MMA(0, 0, At, B0); PG8_MMA(0, 1, At, B1); PG8_BAR; PG8_SCHED;
            PG8_LDA(At, 0, 1); PG8_STAGE(PG8_SB(0, 0), b2, voffB); PG8_STAGE(PG8_SB(0, 1), b2 + hstep, voffB); PG8_STAGE(PG8_SA(0, 0), a2, voffA);
            PG8_WAIT_V(8); PG8_WAIT_L(0); PG8_BAR; PG8_MMA(1, 0, At, B0); PG8_MMA(1, 1, At, B1); PG8_BAR; PG8_SCHED;
            PG8_LDB(B0, 1, 0); PG8_LDB(B1, 1, 1); PG8_SCHED; PG8_LDA(At, 1, 0); PG8_STAGE(PG8_SA(0, 1), a2 + hstep, voffA);
            PG8_WAIT_V(8); PG8_WAIT_L(0); PG8_BAR; PG8_MMA(0, 0, At, B0); PG8_MMA(0, 1, At, B1); PG8_BAR; PG8_SCHED;
            PG8_LDA(At, 1, 1); PG8_STAGE(PG8_SB(1, 0), b3, voffB); PG8_STAGE(PG8_SB(1, 1), b3 + hstep, voffB); PG8_STAGE(PG8_SA(1, 0), a3, voffA);
            PG8_WAIT_V(8); PG8_WAIT_L(0); PG8_BAR; PG8_MMA(1, 0, At, B0); PG8_MMA(1, 1, At, B1); PG8_BAR; PG8_SCHED;
            } else {
            PG8_LDB(B0, 0, 0); PG8_SCHED; PG8_LDA(At, 0, 0); PG8_STAGE(PG8_SA(1, 1), a1 + hstep, voffA);
            PG8_WAIT_L(8); PG8_BAR; PG8_WAIT_L(0); PG8_MMA(0, 0, At, B0); PG8_BAR; PG8_SCHED;
            PG8_LDB(B1, 0, 1); PG8_STAGE(PG8_SB(0, 0), b2, voffB);
            PG8_BAR; PG8_WAIT_L(0); PG8_MMA(0, 1, At, B1); PG8_BAR;
            PG8_LDA(At, 0, 1); PG8_STAGE(PG8_SA(0, 0), a2, voffA);
            PG8_BAR; PG8_WAIT_L(0); PG8_MMA(1, 0, At, B0); PG8_BAR; PG8_SCHED;
            PG8_STAGE(PG8_SB(0, 1), b2 + hstep, voffB);
            PG8_WAIT_V(6); PG8_BAR; PG8_MMA(1, 1, At, B1); PG8_BAR;
            PG8_LDB(B0, 1, 0); PG8_SCHED; PG8_LDA(At, 1, 0); PG8_STAGE(PG8_SA(0, 1), a2 + hstep, voffA);
            PG8_WAIT_L(8); PG8_BAR; PG8_WAIT_L(0); PG8_MMA(0, 0, At, B0); PG8_BAR; PG8_SCHED;
            PG8_LDB(B1, 1, 1); PG8_STAGE(PG8_SB(1, 0), b3, voffB);
            PG8_BAR; PG8_WAIT_L(0); PG8_MMA(0, 1, At, B1); PG8_BAR;
            PG8_LDA(At, 1, 1); PG8_STAGE(PG8_SA(1, 0), a3, voffA);
            PG8_BAR; PG8_WAIT_L(0); PG8_MMA(1, 0, At, B0); PG8_BAR; PG8_SCHED;
            PG8_STAGE(PG8_SB(1, 1), b3 + hstep, voffB);
            PG8_WAIT_V(6); PG8_BAR; PG8_MMA(1, 1, At, B1); PG8_BAR;
            }
        }
        if constexpr (ALIGN_EPI) { if (wr == 0) PG8_BAR; }
        if constexpr (!Epi::AFTER_DRAIN) { E(acc, cur, wr, wc, fr, fq); S.done(cur); }
        if (!has_next) break;
#pragma unroll
        for (int a = 0; a < 2; ++a)
#pragma unroll
            for (int b = 0; b < 2; ++b)
#pragma unroll
                for (int m = 0; m < 4; ++m)
#pragma unroll
                    for (int n = 0; n < 2; ++n) acc[a][b][m][n] = (f32x4){0.f, 0.f, 0.f, 0.f};
        cur = nxt; cA = nA; cB = nB; ++ui;
        if constexpr (ALIGN_EPI) { if (wr == 1) PG8_BAR; }
    }
    PG8_WAIT_V(0);
    if constexpr (!ALIGN_EPI) { if (wr == 0) PG8_BAR; }
    PG8_BAR;
    if constexpr (Epi::AFTER_DRAIN) { E.fused(acc, cur, wr, wc, fr, fq, lds, wid, lane); S.done(cur); }
#undef PG8_SA
#undef PG8_SB
#undef PG8_STAGE
#undef PG8_LDA
#undef PG8_LDB
#undef PG8_MMA
#undef PG8_WAIT_V
#undef PG8_WAIT_L
#undef PG8_BAR
#undef PG8_SCHED
}

template <class Epi, class Sched, bool ALIGN_EPI>
__device__ __forceinline__ void gemm_phase_x(PG8_LAS unsigned char* lds, const Sched& S, const Epi& E) {
    static_assert(Epi::PERM && !Epi::AFTER_DRAIN, "gemm_phase_x: PERM in-loop epilogues only");
    const int tid = threadIdx.x, wid = __builtin_amdgcn_readfirstlane(tid >> 6), lane = tid & 63, wr = wid >> 2, wc = wid & 3, fr = lane & 15, fq = lane >> 4;
    unsigned vA0[2], vB0[2], vA1[2], vB1[2];
#pragma unroll
    for (int i = 0; i < 2; ++i) { int R, C; stage_rc(tid * 16 + i * 8192, R, C); const int Rb = (R & ~31) + perm32(R & 31);
        vA0[i] = (unsigned)(R * 1024 + C) * 2u; vB0[i] = (unsigned)(Rb * 1024 + C) * 2u; vA1[i] = (unsigned)(R * 256 + C) * 2u; vB1[i] = (unsigned)(Rb * 256 + C) * 2u; }
    const size_t kstep = (size_t)(BK * 2);
    const unsigned ldsw = (unsigned)wid * 1024u;
    const int aoff = lds_byte(wr * 64 + fr, fq * 8), boff = lds_byte(wc * 32 + fr, fq * 8);
#define PG8_SA(b, h) (((b) * 2 + (h)) * HTB)
#define PG8_SB(b, h) ((4 + (b) * 2 + (h)) * HTB)
#define PG8_STAGE(bufoff, gbase, voff) do { _Pragma("unroll") for (int _i = 0; _i < 2; ++_i) \
        __builtin_amdgcn_global_load_lds((const unsigned*)((const char*)(gbase) + (voff)[_i]), (PG8_LAS unsigned*)(lds + (bufoff) + ldsw + _i * 8192), 16, 0, 0); } while (0)
#define PG8_LDA(dst, b, h) do { _Pragma("unroll") for (int m = 0; m < 4; ++m) _Pragma("unroll") for (int k = 0; k < 2; ++k) dst[m][k] = *(const PG8_LAS bf16x8*)(lds + PG8_SA(b, h) + aoff + m * 2048 + k * 1024); } while (0)
#define PG8_LDB(dst, b, h) do { _Pragma("unroll") for (int n = 0; n < 2; ++n) _Pragma("unroll") for (int k = 0; k < 2; ++k) dst[n][k] = *(const PG8_LAS bf16x8*)(lds + PG8_SB(b, h) + boff + n * 2048 + k * 1024); } while (0)
#define PG8_MMA(ai, bj, At, Bt) do { __builtin_amdgcn_s_setprio(1); _Pragma("unroll") for (int m = 0; m < 4; ++m) _Pragma("unroll") for (int n = 0; n < 2; ++n) _Pragma("unroll") for (int k = 0; k < 2; ++k) \
        acc[ai][bj][m][n] = __builtin_amdgcn_mfma_f32_16x16x32_bf16(Bt[n][k], At[m][k], acc[ai][bj][m][n], 0, 0, 0); __builtin_amdgcn_s_setprio(0); } while (0)
#define PG8_WAIT_V(n) asm volatile("s_waitcnt vmcnt(" #n ")" ::: "memory")
#define PG8_WAIT_L(n) asm volatile("s_waitcnt lgkmcnt(" #n ")" ::: "memory")
#define PG8_BAR __builtin_amdgcn_s_barrier()
#define PG8_SCHED __builtin_amdgcn_sched_barrier(0)
#define PG8_SELV(dst, sel, a0, a1) do { dst[0] = (sel) ? a1[0] : a0[0]; dst[1] = (sel) ? a1[1] : a0[1]; } while (0)
    UnitX cur, nxt; int ui = 0;
    if (!S.next(0, cur)) return;
    f32x4 acc[2][2][4][2];
#pragma unroll
    for (int a = 0; a < 2; ++a)
#pragma unroll
        for (int b2_ = 0; b2_ < 2; ++b2_)
#pragma unroll
            for (int m = 0; m < 4; ++m)
#pragma unroll
                for (int n = 0; n < 2; ++n) acc[a][b2_][m][n] = (f32x4){0.f, 0.f, 0.f, 0.f};
    bf16x8 At[4][2], B0[2][2], B1[2][2];
    const char* cA = cur.A; const char* cB = cur.B;
    unsigned cvA[2], cvB[2]; PG8_SELV(cvA, cur.ldsel, vA0, vA1); PG8_SELV(cvB, cur.ldsel, vB0, vB1);
    size_t hC = cur.ldsel ? (size_t)HALF * 256 * 2 : (size_t)HALF * 1024 * 2;
    PG8_STAGE(PG8_SB(0, 0), cB, cvB); PG8_STAGE(PG8_SB(0, 1), cB + hC, cvB); PG8_STAGE(PG8_SA(0, 0), cA, cvA); PG8_STAGE(PG8_SA(0, 1), cA + hC, cvA);
    if (wr == 1) PG8_BAR;
    PG8_WAIT_V(2); PG8_BAR;
    PG8_STAGE(PG8_SB(1, 0), cB + kstep, cvB); PG8_STAGE(PG8_SA(1, 0), cA + kstep, cvA); PG8_STAGE(PG8_SB(1, 1), cB + hC + kstep, cvB);
    PG8_WAIT_V(6); PG8_BAR;
    for (;;) {
        const bool has_next = S.next(ui + 1, nxt);
        const char* nA = has_next ? nxt.A : cA; const char* nB = has_next ? nxt.B : cB;
        const int nsel = has_next ? nxt.ldsel : cur.ldsel;
        unsigned nvA[2], nvB[2]; PG8_SELV(nvA, nsel, vA0, vA1); PG8_SELV(nvB, nsel, vB0, vB1);
        const size_t hN = nsel ? (size_t)HALF * 256 * 2 : (size_t)HALF * 1024 * 2;
        const int nt = cur.nt;
        for (int t = 0; t < nt; t += 2) {
            const bool last = (t == nt - 2);
            const char* a1 = cA + (size_t)(t + 1) * kstep;
            const char* a2 = last ? nA : cA + (size_t)(t + 2) * kstep; const char* b2 = last ? nB : cB + (size_t)(t + 2) * kstep;
            const char* a3 = a2 + kstep; const char* b3 = b2 + kstep;
            const size_t h2 = last ? hN : hC;
            unsigned v2A[2], v2B[2]; v2A[0] = last ? nvA[0] : cvA[0]; v2A[1] = last ? nvA[1] : cvA[1]; v2B[0] = last ? nvB[0] : cvB[0]; v2B[1] = last ? nvB[1] : cvB[1];
            PG8_LDB(B0, 0, 0); PG8_LDB(B1, 0, 1); PG8_SCHED; PG8_LDA(At, 0, 0); PG8_STAGE(PG8_SA(1, 1), a1 + hC, cvA);
            PG8_WAIT_V(8); PG8_WAIT_L(0); PG8_BAR; PG8_MMA(0, 0, At, B0); PG8_MMA(0, 1, At, B1); PG8_BAR; PG8_SCHED;
            PG8_LDA(At, 0, 1); PG8_STAGE(PG8_SB(0, 0), b2, v2B); PG8_STAGE(PG8_SB(0, 1), b2 + h2, v2B); PG8_STAGE(PG8_SA(0, 0), a2, v2A);
            PG8_WAIT_V(8); PG8_WAIT_L(0); PG8_BAR; PG8_MMA(1, 0, At, B0); PG8_MMA(1, 1, At, B1); PG8_BAR; PG8_SCHED;
            PG8_LDB(B0, 1, 0); PG8_LDB(B1, 1, 1); PG8_SCHED; PG8_LDA(At, 1, 0); PG8_STAGE(PG8_SA(0, 1), a2 + h2, v2A);
            PG8_WAIT_V(8); PG8_WAIT_L(0); PG8_BAR; PG8_MMA(0, 0, At, B0); PG8_MMA(0, 1, At, B1); PG8_BAR; PG8_SCHED;
            PG8_LDA(At, 1, 1); PG8_STAGE(PG8_SB(1, 0), b3, v2B); PG8_STAGE(PG8_SB(1, 1), b3 + h2, v2B); PG8_STAGE(PG8_SA(1, 0), a3, v2A);
            PG8_WAIT_V(8); PG8_WAIT_L(0); PG8_BAR; PG8_MMA(1, 0, At, B0); PG8_MMA(1, 1, At, B1); PG8_BAR; PG8_SCHED;
        }
        if constexpr (ALIGN_EPI) { if (wr == 0) PG8_BAR; }
        E(acc, cur, wr, wc, fr, fq);
        if (!has_next) break;
#pragma unroll
        for (int a = 0; a < 2; ++a)
#pragma unroll
            for (int b2_ = 0; b2_ < 2; ++b2_)
#pragma unroll
                for (int m = 0; m < 4; ++m)
#pragma unroll
                    for (int n = 0; n < 2; ++n) acc[a][b2_][m][n] = (f32x4){0.f, 0.f, 0.f, 0.f};
        cur = nxt; cA = nA; cB = nB; cvA[0] = nvA[0]; cvA[1] = nvA[1]; cvB[0] = nvB[0]; cvB[1] = nvB[1]; hC = hN; ++ui;
        if constexpr (ALIGN_EPI) { if (wr == 1) PG8_BAR; }
    }
    PG8_WAIT_V(0);
    if constexpr (!ALIGN_EPI) { if (wr == 0) PG8_BAR; }
    PG8_BAR;
#undef PG8_SA
#undef PG8_SB
#undef PG8_STAGE
#undef PG8_LDA
#undef PG8_LDB
#undef PG8_MMA
#undef PG8_WAIT_V
#undef PG8_WAIT_L
#undef PG8_BAR
#undef PG8_SCHED
#undef PG8_SELV
}
}

#ifndef PG8_SP2
#define PG8_SP2 true
#endif
#ifndef PG8_ALIGN
#define PG8_ALIGN true
#endif
constexpr int NWAVES = 8;
constexpr int BATCH = 2, SEQ = 8192, DM = 1024, M = BATCH * SEQ, DIN = 3328, DPLE = 256, NL = 2, NH = 8, HD = 64, NBLK = 32;
constexpr int DIN_MAIN = 3072;
constexpr int ZQ = 0, ZK = 512, ZV = 1024, ZGA = 1536, ZXB = 2048, ZGB = 2304, ZUC = 2560, ZVC = 2816, ZGC = 3072;
constexpr float C2 = 0.125f * 1.4426950408889634f;
constexpr float LOG2E = 1.4426950408889634f;
constexpr int NBIAS = 129;
constexpr size_t MiB = 1u << 20, KiB = 1u << 10;
constexpr size_t WS_CTL = 0, CTL_ZERO_BYTES = 1 * MiB;
constexpr size_t CTL_KSUM = 512 * KiB;
constexpr size_t CTL_NTOT = 768 * KiB;
constexpr size_t CTL_NNEAR = 776 * KiB;
constexpr size_t WS_WIN = 1 * MiB, WIN_BYTES = (size_t)DIN * DM * 2;
constexpr size_t WS_WOUT = 14 * MiB, WS_WGATE = 18 * MiB, WS_WPLE = 22 * MiB;
constexpr size_t WS_SGUW = 23 * MiB;
constexpr size_t WS_POOLWT = 23 * MiB + 256 * KiB;
constexpr size_t WS_BIAS2 = 23 * MiB + 512 * KiB;
constexpr size_t WS_SSQ = 23 * MiB + 768 * KiB;
constexpr size_t WS_STATS = 24 * MiB;
constexpr size_t WS_PB = 26 * MiB;
constexpr size_t WS_XN = 42 * MiB;
constexpr size_t WS_Z = 74 * MiB;
constexpr size_t WS_OPART = 178 * MiB;
constexpr size_t WS_LSE = 242 * MiB;
constexpr size_t WS_H1B = 178 * MiB, WS_TB = 210 * MiB;
constexpr size_t WS_GCPART = 178 * MiB;
constexpr size_t WS_LISTS = 244 * MiB;
constexpr size_t WS_CNT = 252 * MiB;
constexpr size_t WS_END = 253 * MiB;
constexpr int CW_TMO = 0, CW_CODE = 1, CW_BAR = 4096;
constexpr int RING_OFF = 0, RING_BYTES = 131072;
constexpr int LDSCTL_OFF = RING_BYTES, MISC_OFF = LDSCTL_OFF + 320;
constexpr int LDS_BYTES = 147456;


#ifndef REP_ATTN
#define REP_ATTN 1
#endif
#ifndef REP_COMB
#define REP_COMB 1
#endif
#ifndef REP_MIX
#define REP_MIX 1
#endif
#ifndef REP_SGU
#define REP_SGU 1
#endif
#ifndef REP_POOL
#define REP_POOL 1
#endif
#ifndef REP_GATE
#define REP_GATE 1
#endif
#ifndef REP_GEMM1
#define REP_GEMM1 1
#endif
#ifndef REP_PRO
#define REP_PRO 1
#endif
#ifndef REP_BAR
#define REP_BAR 1
#endif
#ifndef REP_OUT0
#define REP_OUT0 1
#endif
#ifndef REPB
#define REPB 0
#endif
#ifndef REP_T
#define REP_T 1
#endif
#ifndef REP_SIG
#define REP_SIG 1
#endif

#define GAS __attribute__((address_space(1)))
#define LAS __attribute__((address_space(3)))
typedef unsigned short bf16;
typedef unsigned v4u __attribute__((ext_vector_type(4)));
typedef float f32x4 __attribute__((ext_vector_type(4)));
typedef short bf16x8 __attribute__((ext_vector_type(8)));
typedef GAS unsigned gu32;
typedef GAS unsigned long long gu64;
#define RLX_AGENT __ATOMIC_RELAXED, __HIP_MEMORY_SCOPE_AGENT
#define LDS_WAIT() asm volatile("s_waitcnt lgkmcnt(0)" ::: "memory")
#define VM_WAIT() asm volatile("s_waitcnt vmcnt(0)" ::: "memory")
__device__ __forceinline__ unsigned long long rt() { return __builtin_amdgcn_s_memrealtime(); }
__device__ __forceinline__ unsigned f2bf(float f) { unsigned u = __builtin_bit_cast(unsigned, f); return (u + 0x7fffu + ((u >> 16) & 1u)) >> 16; }
__device__ __forceinline__ unsigned pk2(float lo, float hi) { return f2bf(lo) | (f2bf(hi) << 16); }

#define XB_TMO      128
#define XB_XCNT(j)  (256  + 64 * (j))
#define XB_XSUB(j)  (1280 + 64 * (j))
#define XB_XGEN(j)  (2304 + 64 * (j))
#define XB_TOP      3328
#define XB_TOPGEN   3392
#define XCD_BAR_WORDS 3456
#define XB_SPIN_CAP (1u << 18)

__device__ __forceinline__ unsigned xb_ld(unsigned* p)              { return __hip_atomic_load(p, __ATOMIC_RELAXED, __HIP_MEMORY_SCOPE_AGENT); }
__device__ __forceinline__ unsigned xb_add(unsigned* p, unsigned v) { return __hip_atomic_fetch_add(p, v, __ATOMIC_RELAXED, __HIP_MEMORY_SCOPE_AGENT); }
__device__ __forceinline__ unsigned xb_xcc_id() { return (unsigned)__builtin_amdgcn_s_getreg((3 << 11) | 20) & 0xFu; }
#define XB_SPIN(cond, bar) do { unsigned _sp = 0; while (cond) { __builtin_amdgcn_s_sleep(1); \
    if ((++_sp & 255u) == 0u) { if (xb_ld(&(bar)[XB_TMO])) break; if (_sp > XB_SPIN_CAP) { atomicAdd(&(bar)[XB_TMO], 1u); break; } } } } while (0)

struct XcdBarrier {
    unsigned* bar; unsigned x;
    volatile LAS unsigned* st;
};

__device__ __forceinline__ XcdBarrier xcd_barrier_post(unsigned* bar, volatile LAS unsigned* st) {
    XcdBarrier b; b.bar = bar; b.x = xb_xcc_id(); b.st = st;
    if (threadIdx.x == 0) (void)xb_add(&bar[XB_XCNT(b.x)], 1u);
    return b;
}
__device__ __forceinline__ void xcd_barrier_complete(unsigned* bar, unsigned x, unsigned& nloc, unsigned& nx) {
    const unsigned G = gridDim.x * gridDim.y * gridDim.z;
    unsigned sum, cnt, mine, sp = 0u;
    for (;;) {
        sum = 0u; cnt = 0u; mine = 0u;
#pragma unroll
        for (unsigned j = 0; j < 16; ++j) { const unsigned c = xb_ld(&bar[XB_XCNT(j)]); sum += c; cnt += (c > 0u) ? 1u : 0u; mine = (j == x) ? c : mine; }
        if (sum == G) break;
        __builtin_amdgcn_s_sleep(1);
        if ((++sp & 255u) == 0u) { if (xb_ld(&bar[XB_TMO])) break; if (sp > XB_SPIN_CAP) { atomicAdd(&bar[XB_TMO], 1u); break; } }
    }
    nloc = mine > 0u ? mine : 1u; nx = cnt > 0u ? cnt : 1u;
}

__device__ __forceinline__ void xcd_barrier(const XcdBarrier& b) {
    asm volatile("s_waitcnt vmcnt(0)" ::: "memory");
    __syncthreads();
    if (threadIdx.x == 0) {
        unsigned* bar = b.bar;
        __builtin_amdgcn_s_waitcnt(0);
        unsigned nloc = b.st[0], nx = b.st[1];
        if (nloc == 0u) { xcd_barrier_complete(bar, b.x, nloc, nx); b.st[0] = nloc; b.st[1] = nx; }
        const unsigned old = xb_add(&bar[XB_XSUB(b.x)], 1u);
        const unsigned gen = old / nloc;
        if (old + 1u == (gen + 1u) * nloc) {
            __builtin_amdgcn_fence(__ATOMIC_RELEASE, "agent");
            asm volatile("s_waitcnt vmcnt(0)" ::: "memory");
            const unsigned og = xb_add(&bar[XB_TOP], 1u);
            const unsigned tg = og / nx;
            if (og + 1u == (tg + 1u) * nx) xb_add(&bar[XB_TOPGEN], 1u);
            else XB_SPIN(xb_ld(&bar[XB_TOPGEN]) == tg, bar);
            __builtin_amdgcn_fence(__ATOMIC_ACQUIRE, "agent");
            xb_add(&bar[XB_XGEN(b.x)], 1u);
            asm volatile("s_waitcnt vmcnt(0)" ::: "memory");
        } else {
            XB_SPIN(xb_ld(&bar[XB_XGEN(b.x)]) == gen, bar);
            __builtin_amdgcn_fence(__ATOMIC_ACQUIRE, "agent");
            asm volatile("s_waitcnt vmcnt(0)" ::: "memory");
        }
    }
    __syncthreads();
}
namespace pg8 {
struct EpiPleFinal {
    static constexpr bool PERM = true, AFTER_DRAIN = true;
    const bf16_t* T; const bf16_t* h1; float* out; const float* fg; float* ssq; XcdBarrier bar;
    __device__ __forceinline__ void fused(f32x4 (&acc)[2][2][4][2], const Unit& u, int wr, int wc, int fr, int fq, PG8_LAS unsigned char* lds, int wid, int lane) const {
        PG8_LAS float* P = (PG8_LAS float*)lds;
        PG8_LAS float* S = (PG8_LAS float*)(lds + 4096);
        const int col0 = u.pn * BM + wc * 32 + 8 * fq;
#pragma unroll
        for (int ai = 0; ai < 2; ++ai)
#pragma unroll
            for (int m = 0; m < 4; ++m) {
                const int rl = ai * HALF + wr * 64 + m * 16 + fr;
                const size_t off = (size_t)(u.pm * BM + rl) * 1024 + col0;
                float q = 0.f;
#pragma unroll
                for (int bj = 0; bj < 2; ++bj) {
                    const u32x4 tw = *(const u32x4*)(T + off + bj * HALF), hw = *(const u32x4*)(h1 + off + bj * HALF);
                    const f32x4 t0 = (f32x4){bf_lo(tw.x), bf_hi(tw.x), bf_lo(tw.y), bf_hi(tw.y)}, t1 = (f32x4){bf_lo(tw.z), bf_hi(tw.z), bf_lo(tw.w), bf_hi(tw.w)};
                    const f32x4 h0 = (f32x4){bf_lo(hw.x), bf_hi(hw.x), bf_lo(hw.y), bf_hi(hw.y)}, h1v = (f32x4){bf_lo(hw.z), bf_hi(hw.z), bf_lo(hw.w), bf_hi(hw.w)};
                    f32x4 s0 = acc[ai][bj][m][0], s1 = acc[ai][bj][m][1];
#pragma unroll
                    for (int i = 0; i < 4; ++i) { s0[i] = __builtin_amdgcn_rcpf(1.f + __expf(-s0[i])); s1[i] = __builtin_amdgcn_rcpf(1.f + __expf(-s1[i])); }
                    const f32x4 o0 = h0 + t0 * s0, o1 = h1v + t1 * s1;
                    q += (o0[0] * o0[0] + o0[1] * o0[1]) + (o0[2] * o0[2] + o0[3] * o0[3]) + (o1[0] * o1[0] + o1[1] * o1[1]) + (o1[2] * o1[2] + o1[3] * o1[3]);
                    acc[ai][bj][m][0] = o0; acc[ai][bj][m][1] = o1;
                }
                q += __shfl_xor(q, 16); q += __shfl_xor(q, 32);
                if (fq == 0) P[rl * 4 + wc] = q;
                asm volatile("" : "+v"(acc[ai][0][m][0]), "+v"(acc[ai][0][m][1]), "+v"(acc[ai][1][m][0]), "+v"(acc[ai][1][m][1]));
                asm volatile("" ::: "memory");
            }
        asm volatile("s_waitcnt lgkmcnt(0)" ::: "memory"); __builtin_amdgcn_s_barrier(); asm volatile("" ::: "memory");
        const int t = wid * 64 + lane;
        if (t < 256) { const float s = (P[t * 4 + 0] + P[t * 4 + 1]) + (P[t * 4 + 2] + P[t * 4 + 3]); ssq[(size_t)(u.pm * BM + t) * 4 + u.pn] = s; }
        xcd_barrier(bar);
        if (t < 256) { const f32x4 s4 = *(const f32x4*)(ssq + (size_t)(u.pm * BM + t) * 4); S[t] = 1.0f / sqrtf(((s4[0] + s4[1]) + (s4[2] + s4[3])) * (1.0f / 1024.0f) + 1e-6f); }
        asm volatile("s_waitcnt lgkmcnt(0)" ::: "memory"); __builtin_amdgcn_s_barrier(); asm volatile("" ::: "memory");
        f32x4 gv[2][2];
#pragma unroll
        for (int bj = 0; bj < 2; ++bj) { gv[bj][0] = *(const f32x4*)(fg + col0 + bj * HALF); gv[bj][1] = *(const f32x4*)(fg + col0 + bj * HALF + 4); }
#pragma unroll
        for (int ai = 0; ai < 2; ++ai)
#pragma unroll
            for (int m = 0; m < 4; ++m) {
                const int rl = ai * HALF + wr * 64 + m * 16 + fr; const float rs = S[rl];
                const size_t off = (size_t)(u.pm * BM + rl) * 1024 + col0;
#pragma unroll
                for (int bj = 0; bj < 2; ++bj) { *(f32x4*)(out + off + bj * HALF) = acc[ai][bj][m][0] * rs * gv[bj][0]; *(f32x4*)(out + off + bj * HALF + 4) = acc[ai][bj][m][1] * rs * gv[bj][1]; }
            }
    }
};
}
struct Frame {
    LAS unsigned char* lds;
    volatile LAS unsigned* MISC;
    gu32* ctl;
    int tid, lane, wave, vcu, G;
};
__device__ __forceinline__ float wave_sum(float v) {
#pragma unroll
    for (int o = 1; o < 64; o <<= 1) v += __shfl_xor(v, o);
    return v;
}
__device__ __forceinline__ float bf2f(bf16 v) { return __uint_as_float((unsigned)v << 16); }
__device__ __forceinline__ float silu_f(float x) { return x / (1.f + __expf(-x)); }
__device__ __forceinline__ int t5_bucket(int n) {
    if (n < 16) return n;
    const float v = logf((float)n / 16.f) / 2.0794415416798357f * 16.f;
    const int l = 16 + (int)v;
    return l < 31 ? l : 31;
}
__device__ __forceinline__ void p0_transpose_item(const float* W, int K, int N, bf16* WT, LAS float* scr, int item, int lane, const float* gk = nullptr) {
    const int nblk = N / 32, kb = item / nblk, nb = item % nblk, k0 = 64 * kb, n0 = 32 * nb;
    float wv[32];
#pragma unroll
    for (int i = 0; i < 32; ++i) { const int kk = 2 * i + (lane >> 5); wv[i] = W[(size_t)(k0 + kk) * N + n0 + (lane & 31)]; }
    if (gk) {
#pragma unroll
        for (int i = 0; i < 32; ++i) wv[i] *= gk[k0 + 2 * i + (lane >> 5)]; }
#pragma unroll
    for (int i = 0; i < 32; ++i) { const int kk = 2 * i + (lane >> 5); scr[kk * 33 + (lane & 31)] = wv[i]; }
    LDS_WAIT(); asm volatile("" ::: "memory");
    const int c = lane & 7;
#pragma unroll
    for (int j = 0; j < 4; ++j) { const int n = (lane >> 3) + 8 * j; const LAS float* s = scr + (8 * c) * 33 + n;
        v4u o; o.x = pk2(s[0 * 33], s[1 * 33]); o.y = pk2(s[2 * 33], s[3 * 33]); o.z = pk2(s[4 * 33], s[5 * 33]); o.w = pk2(s[6 * 33], s[7 * 33]);
        *(GAS v4u*)(WT + (size_t)(n0 + n) * K + k0 + 8 * c) = o; }
    LDS_WAIT(); asm volatile("" ::: "memory");
}
struct Args { const float* in[13]; float* out; unsigned char* ws; int ph_lo, ph_hi, li, pad; };

template <int PART> __device__ __forceinline__ void p0_prologue(Frame& F, const Args& A) {
    unsigned char* ws = A.ws;
    LAS float* scr = (LAS float*)(F.lds + RING_OFF + F.wave * 16384);
    const int gw = F.vcu * NWAVES + F.wave, NGW = F.G * NWAVES;
    constexpr int I_IN = (DM / 64) * (DIN / 32), I_OUT = (DM / 64) * (DM / 32), I_GATE = I_OUT, I_PLE = (DPLE / 64) * (DM / 32), PL = I_IN + I_OUT + I_GATE + I_PLE;
    if (PART == 0) {
        for (int it = gw; it < I_IN + I_PLE; it += NGW) {
            if (it < I_IN) p0_transpose_item(A.in[3], DM, DIN, (bf16*)(ws + WS_WIN), scr, it, F.lane, A.in[2]);
            else p0_transpose_item(A.in[10], DPLE, DM, (bf16*)(ws + WS_WPLE), scr, it - I_IN, F.lane);
        }
    } else {
        for (int it = gw; it < I_OUT + I_GATE + PL; it += NGW) {
            int r = it;
            if (r < I_OUT) { p0_transpose_item(A.in[4], DM, DM, (bf16*)(ws + WS_WOUT), scr, r, F.lane); continue; } r -= I_OUT;
            if (r < I_GATE) { p0_transpose_item(A.in[11], DM, DM, (bf16*)(ws + WS_WGATE), scr, r, F.lane); continue; } r -= I_GATE;
            constexpr int L = 1;
            if (r < I_IN) { p0_transpose_item(A.in[3] + (size_t)L * DM * DIN, DM, DIN, (bf16*)(ws + WS_WIN + L * WIN_BYTES), scr, r, F.lane, A.in[2] + (size_t)L * DM); continue; } r -= I_IN;
            if (r < I_OUT) { p0_transpose_item(A.in[4] + (size_t)L * DM * DM, DM, DM, (bf16*)(ws + WS_WOUT + L * 2 * MiB), scr, r, F.lane); continue; } r -= I_OUT;
            if (r < I_GATE) { p0_transpose_item(A.in[11] + (size_t)L * DM * DM, DM, DM, (bf16*)(ws + WS_WGATE + L * 2 * MiB), scr, r, F.lane); continue; } r -= I_GATE;
            p0_transpose_item(A.in[10] + (size_t)L * DPLE * DM, DPLE, DM, (bf16*)(ws + WS_WPLE + L * 512 * KiB), scr, r, F.lane);
        }
    }
    const int gt = gw * 64 + F.lane, NT = NGW * 64;
    { const GAS f32x4* p4 = (const GAS f32x4*)A.in[1] + (size_t)PART * (M * DPLE / 4); GAS v4u* dst = (GAS v4u*)(ws + WS_PB) + (size_t)PART * (M * DPLE / 8);
      for (int i0 = gt; i0 < M * DPLE / 8; i0 += 4 * NT) { f32x4 a[4], b[4];
#pragma unroll
          for (int q = 0; q < 4; ++q) { const int i = i0 + q * NT; if (i < M * DPLE / 8) { a[q] = p4[2 * (size_t)i]; b[q] = p4[2 * (size_t)i + 1]; } }
#pragma unroll
          for (int q = 0; q < 4; ++q) { const int i = i0 + q * NT; if (i < M * DPLE / 8) { v4u o; o.x = pk2(a[q].x, a[q].y); o.y = pk2(a[q].z, a[q].w); o.z = pk2(b[q].x, b[q].y); o.w = pk2(b[q].z, b[q].w); dst[i] = o; } } } }
    if (PART == 1) return;
    {
        const float* sw = A.in[8]; bf16* dsw = (bf16*)(ws + WS_SGUW);
        const float* pw = A.in[6]; bf16* dpw = (bf16*)(ws + WS_POOLWT);
        const float* rb = A.in[5]; float* drb = (float*)(ws + WS_BIAS2);
        constexpr int N_SW = NL * 4 * 128 * 128, N_PW = NL * 4 * 64 * 64, N_RB = NH * NBIAS;
        float v_sw = 0.f, v_pw = 0.f, v_rb = 0.f;
        if (gt < N_SW) v_sw = sw[gt];
        if (gt < N_PW) v_pw = pw[(size_t)(gt >> 12) * 4096 + (gt & 63) * 64 + ((gt >> 6) & 63)];
        if (gt < N_RB) v_rb = rb[t5_bucket(gt % NBIAS) * NH + gt / NBIAS];
        asm volatile("" ::: "memory");
        if (gt < N_SW) dsw[gt] = (bf16)f2bf((gt & 127) <= ((gt >> 7) & 127) ? v_sw : 0.f);
        if (gt < N_PW) dpw[gt] = (bf16)f2bf(v_pw);
        if (gt < N_RB) drb[gt] = v_rb * LOG2E;
        for (int i = gt + NT; i < N_SW; i += NT) { const int t = (i >> 7) & 127, s = i & 127; dsw[i] = (bf16)f2bf(s <= t ? sw[i] : 0.f); }
        for (int i = gt + NT; i < N_PW; i += NT) { const int lg = i >> 12, d = (i >> 6) & 63, c = i & 63; dpw[i] = (bf16)f2bf(pw[(size_t)lg * 4096 + c * 64 + d]); }
        for (int i = gt + NT; i < N_RB; i += NT) { const int h = i / NBIAS, n = i % NBIAS; drb[i] = rb[t5_bucket(n) * NH + h] * LOG2E; }
    }
    { constexpr int XB = 8; const float* x = A.in[0]; bf16* xn = (bf16*)((unsigned char*)A.out + 32 * MiB); float* ssq = (float*)(ws + WS_SSQ);
      for (int mi = 0; mi < M / NGW; mi += XB) { const int m0 = gw * (M / NGW) + mi;
          f32x4 v[XB][4];
#pragma unroll
          for (int r = 0; r < XB; ++r) { const GAS f32x4* xr = (const GAS f32x4*)(x + (size_t)(m0 + r) * DM) + F.lane;
#pragma unroll
              for (int j = 0; j < 4; ++j) v[r][j] = xr[64 * j]; }
#pragma unroll
          for (int r = 0; r < XB; ++r) { GAS unsigned long long* o8 = (GAS unsigned long long*)(xn + (size_t)(m0 + r) * DM) + F.lane;
              float s = 0.f;
#pragma unroll
              for (int j = 0; j < 4; ++j) { const f32x4 w = v[r][j]; s += (w.x * w.x + w.y * w.y) + (w.z * w.z + w.w * w.w);
                  o8[64 * j] = (unsigned long long)pk2(w.x, w.y) | ((unsigned long long)pk2(w.z, w.w) << 32); }
              s = wave_sum(s);
              if (F.lane == 0) *(GAS f32x4*)(ssq + (size_t)(m0 + r) * 4) = (f32x4){s, 0.f, 0.f, 0.f}; }
      } }
}
typedef float f32x16 __attribute__((ext_vector_type(16)));
typedef short s16x4 __attribute__((ext_vector_type(4)));
typedef short v4i16_t __attribute__((ext_vector_type(4)));
constexpr int A_K = 0, A_V = 32768, A_ROWTAB = 65536, A_WSF = 66560, A_OST = 68608, A_BIAS = 109312, A_PREF = 102400, A_NT = 104960, A_UD = 107008, A_NN = 107264;
#ifndef ATT_THR
#define ATT_THR 8.0f
#endif
constexpr int NREV = 448;
constexpr int NEAR_OFF = 8064;
__device__ __forceinline__ int crow(int r, int hi) { return (r & 3) + 8 * (r >> 2) + 4 * hi; }
__device__ __forceinline__ unsigned cvtpk_s(float lo, float hi) { typedef float f2 __attribute__((ext_vector_type(2))); typedef __bf16 b2 __attribute__((ext_vector_type(2))); f2 v = {lo, hi}; b2 b = __builtin_convertvector(v, b2); return __builtin_bit_cast(unsigned, b); }
__device__ __forceinline__ s16x4 vtr(const LAS unsigned char* p) { return __builtin_bit_cast(s16x4, __builtin_amdgcn_ds_read_tr16_b64_v4i16((LAS v4i16_t*)p)); }
__device__ __forceinline__ float swap_max(float m) { auto rr = __builtin_amdgcn_permlane32_swap(__float_as_uint(m), __float_as_uint(m), false, false); return __builtin_fmaxf(__uint_as_float(rr[0]), __uint_as_float(rr[1])); }
#ifdef FAR_SPLAT
#define FARC bfar
#else
#define FARC 0.f
#endif
#ifdef NO_ASM_MAX
__device__ __forceinline__ float max3f_(float a, float b, float c) { return __builtin_fmaxf(__builtin_fmaxf(a, b), c); }
#else
__device__ __forceinline__ float max3f_(float a, float b, float c) { float r; asm("v_max3_f32 %0, %1, %2, %3" : "=v"(r) : "v"(a), "v"(b), "v"(c)); return r; }
#endif
__device__ __forceinline__ float swap_add(float m) { auto rr = __builtin_amdgcn_permlane32_swap(__float_as_uint(m), __float_as_uint(m), false, false); return __uint_as_float(rr[0]) + __uint_as_float(rr[1]); }

typedef unsigned short u16;
__device__ __forceinline__ void unpack8(const v4u w, float* f) {
    f[0] = __uint_as_float(w.x << 16); f[1] = __uint_as_float(w.x & 0xffff0000u); f[2] = __uint_as_float(w.y << 16); f[3] = __uint_as_float(w.y & 0xffff0000u);
    f[4] = __uint_as_float(w.z << 16); f[5] = __uint_as_float(w.z & 0xffff0000u); f[6] = __uint_as_float(w.w << 16); f[7] = __uint_as_float(w.w & 0xffff0000u);
}
typedef unsigned v2u __attribute__((ext_vector_type(2)));
constexpr int SGU_PITCH = 272, POOL_PITCH = 528;
constexpr int SGU_ST_OFF = 132096;
constexpr int N_GATE_UNITS = 16 * 31, N_POOL_WU = (M / 32) * 4, N_SGU_WU = (M / 128) * 4 * 4;

__device__ __forceinline__ bf16x8 tr_frag(const LAS unsigned char* blk, const int lane) {
    const int hi = lane >> 5; const LAS unsigned char* p = blk + ((lane >> 4) & 1) * 32 + (lane & 3) * 8 + (4 * hi + ((lane & 15) >> 2)) * 64;
    const s16x4 lo = vtr(p), hh = vtr(p + 512);
    return (bf16x8){lo[0], lo[1], lo[2], lo[3], hh[0], hh[1], hh[2], hh[3]};
}
__device__ __forceinline__ bf16x8 ld_perm8(const bf16* p) {
    const v2u a = *(const v2u*)p, b = *(const v2u*)(p + 8); const v4u w = (v4u){a.x, a.y, b.x, b.y}; return __builtin_bit_cast(bf16x8, w);
}
__device__ __forceinline__ void pool_wave(Frame& F, const Args& A, const int L, const int wu) {
    unsigned char* ws = A.ws; const bf16* Z = (const bf16*)(ws + WS_Z); bf16* Y = (bf16*)(ws + WS_XN);
    const int lane = F.lane, r32 = lane & 31, hi = lane >> 5, gi = wu & 3, tile = wu >> 2, m0 = tile * 32, t0 = m0 & (SEQ - 1), w = 2 << gi;
    LAS unsigned char* X = F.lds + F.wave * 16384;
#pragma unroll
    for (int k = 0; k < 6; ++k) { const int p = lane + 64 * k, row = p >> 3, pc = p & 7; const int ts = t0 - 16 + row;
        v4u v = (v4u){0u, 0u, 0u, 0u};
        if (ts >= 0) v = *(const v4u*)(Z + (size_t)(m0 - 16 + row) * DIN + ZXB + gi * 64 + pc * 8);
        *(LAS v4u*)(X + (pc >> 2) * 4096 + (row >> 4) * 1024 + (row & 15) * 64 + (pc & 3) * 16) = v; }
    const bf16* WT = (const bf16*)(ws + WS_POOLWT) + (size_t)(L * 4 + gi) * 4096;
    const float* psc = A.in[7] + (size_t)L * 256 + gi * 64; const size_t m = (size_t)(m0 + r32);
    bf16x8 wfr[2][4]; v2u gwe[2][4]; f32x4 sce[2][4];
#pragma unroll
    for (int dt = 0; dt < 2; ++dt)
#pragma unroll
        for (int q4 = 0; q4 < 4; ++q4) { wfr[dt][q4] = ld_perm8(WT + (dt * 32 + r32) * 64 + 16 * q4 + 4 * hi); const int d4 = dt * 32 + 8 * q4 + 4 * hi;
            gwe[dt][q4] = *(const v2u*)(Z + m * DIN + ZGB + gi * 64 + d4); sce[dt][q4] = *(const f32x4*)(psc + d4); }
    const int tt = t0 + r32; const float inv = 1.f / (float)((tt + 1 < w) ? tt + 1 : w);
    bf16x8 bnd[3];
#pragma unroll
    for (int ks = 0; ks < 3; ++ks) { unsigned wv[4];
#pragma unroll
        for (int jj = 0; jj < 4; ++jj) { float c2[2];
#pragma unroll
            for (int e = 0; e < 2; ++e) { const int j = 2 * jj + e, sl = 16 * ks + 8 * (j >> 2) + 4 * hi + (j & 3), d = r32 + 16 - sl, sa = t0 - 16 + sl;
                c2[e] = ((d >= 0 && d < w && sa >= 0) ? inv : 0.f) - (d == 0 ? 1.f : 0.f); }
            wv[jj] = pk2(c2[0], c2[1]); }
        bnd[ks] = __builtin_bit_cast(bf16x8, (v4u){wv[0], wv[1], wv[2], wv[3]}); }
    f32x16 pt[2];
#pragma unroll
    for (int mt = 0; mt < 2; ++mt) {
#pragma unroll
        for (int r = 0; r < 16; ++r) pt[mt][r] = 0.f;
#pragma unroll
        for (int ks = 0; ks < 3; ++ks) pt[mt] = __builtin_amdgcn_mfma_f32_32x32x16_bf16(tr_frag(X + mt * 4096 + ks * 1024, lane), bnd[ks], pt[mt], 0, 0, 0);
    }
    f32x16 yt[2];
#pragma unroll
    for (int dt = 0; dt < 2; ++dt) {
#pragma unroll
        for (int r = 0; r < 16; ++r) yt[dt][r] = 0.f;
#pragma unroll
        for (int s2 = 0; s2 < 4; ++s2) { const int mt = s2 >> 1, rb = 8 * (s2 & 1);
            const v4u pw = (v4u){cvtpk_s(pt[mt][rb + 0], pt[mt][rb + 1]), cvtpk_s(pt[mt][rb + 2], pt[mt][rb + 3]), cvtpk_s(pt[mt][rb + 4], pt[mt][rb + 5]), cvtpk_s(pt[mt][rb + 6], pt[mt][rb + 7])};
            yt[dt] = __builtin_amdgcn_mfma_f32_32x32x16_bf16(wfr[dt][s2], __builtin_bit_cast(bf16x8, pw), yt[dt], 0, 0, 0); }
    }
#pragma unroll
    for (int dt = 0; dt < 2; ++dt)
#pragma unroll
        for (int g = 0; g < 4; ++g) { const int d4 = dt * 32 + 8 * g + 4 * hi;
            const v2u gw = gwe[dt][g]; const f32x4 sc = sce[dt][g];
            const float o0 = yt[dt][4 * g + 0] * sc[0] * silu_f(__uint_as_float(gw.x << 16)), o1 = yt[dt][4 * g + 1] * sc[1] * silu_f(__uint_as_float(gw.x & 0xffff0000u));
            const float o2 = yt[dt][4 * g + 2] * sc[2] * silu_f(__uint_as_float(gw.y << 16)), o3 = yt[dt][4 * g + 3] * sc[3] * silu_f(__uint_as_float(gw.y & 0xffff0000u));
            v2u o; o.x = pk2(o0, o1); o.y = pk2(o2, o3);
            *(v2u*)(Y + m * DM + 512 + gi * 64 + d4) = o; }
}
__device__ __forceinline__ void sgu_wave(Frame& F, const Args& A, const int L, const int wu) {
    unsigned char* ws = A.ws; const bf16* Z = (const bf16*)(ws + WS_Z); bf16* Y = (bf16*)(ws + WS_XN);
    const int lane = F.lane, r32 = lane & 31, hi = lane >> 5, nt = wu & 3, hh = (wu >> 2) & 3, chunk = wu >> 4, m0 = chunk * 128;
    LAS unsigned char* X = F.lds + F.wave * 16384;
    const float* vst = (const float*)(ws + WS_STATS);
    const bf16* W = (const bf16*)(ws + WS_SGUW) + (size_t)(L * 4 + hh) * 128 * 128;
    const bf16* wrow = W + (size_t)(nt * 32 + r32) * 128 + 4 * hi;
    const int lim = 2 * nt + 2;
    bf16x8 bw[8];
#pragma unroll
    for (int ks = 0; ks < 8; ++ks) if (ks < lim) bw[ks] = ld_perm8(wrow + 16 * ks);
    const int tl = nt * 32 + r32; const size_t m = (size_t)(m0 + tl);
    const float bb = (A.in[9] + (size_t)(L * 4 + hh) * 128)[tl];
    v2u uw[2][4];
#pragma unroll
    for (int mt = 0; mt < 2; ++mt)
#pragma unroll
        for (int g = 0; g < 4; ++g) { const int c4 = hh * 64 + mt * 32 + 8 * g + 4 * hi; uw[mt][g] = *(const v2u*)(Z + m * DIN + ZUC + c4); }
    const float* gp0 = (const float*)(ws + WS_GCPART) + m * 256, * gp1 = gp0 + (size_t)M * 256;
    const f32x4 s4 = *(const f32x4*)((const float*)(ws + WS_SSQ) + m * 4);
    const float rsm = 1.0f / sqrtf(((s4[0] + s4[1]) + (s4[2] + s4[3])) * (1.0f / 1024.0f) + 1e-6f);
    LAS float* stt = (LAS float*)(F.lds + SGU_ST_OFF + F.wave * 1024);
    const int nrows = 32 * nt + 32, npc = 4 * (nt + 1);
    f32x4 sa[2], sb[2];
#pragma unroll
    for (int q2 = 0; q2 < 2; ++q2) { const int row = lane + 64 * q2; if (row < nrows) { sa[q2] = *(const f32x4*)(vst + (size_t)(m0 + row) * 8); sb[q2] = *(const f32x4*)(vst + (size_t)(m0 + row) * 8 + 4); } }
    v4u dat[16];
#pragma unroll
    for (int k = 0; k < 16; ++k) if (k < npc) { const int p = lane + 64 * k, row = p >> 3, pc = p & 7; dat[k] = *(const v4u*)(Z + (size_t)(m0 + row) * DIN + ZVC + hh * 64 + pc * 8); }
#pragma unroll
    for (int q2 = 0; q2 < 2; ++q2) { const int row = lane + 64 * q2; if (row < nrows) {
        const float mu = ((sa[q2][0] + sa[q2][2]) + (sb[q2][0] + sb[q2][2])) * (1.f / 256.f), ex2 = ((sa[q2][1] + sa[q2][3]) + (sb[q2][1] + sb[q2][3])) * (1.f / 256.f);
        stt[2 * row] = mu; stt[2 * row + 1] = 1.0f / sqrtf(fmaxf(ex2 - mu * mu, 0.f) + 1e-6f); } }
#pragma unroll
    for (int k = 0; k < 16; ++k) if (k < npc) { const int p = lane + 64 * k, row = p >> 3, pc = p & 7;
        const float mu = stt[2 * row], rstd = stt[2 * row + 1];
        float f[8]; unpack8(dat[k], f);
        v4u o; o.x = pk2((f[0] - mu) * rstd, (f[1] - mu) * rstd); o.y = pk2((f[2] - mu) * rstd, (f[3] - mu) * rstd); o.z = pk2((f[4] - mu) * rstd, (f[5] - mu) * rstd); o.w = pk2((f[6] - mu) * rstd, (f[7] - mu) * rstd);
        *(LAS v4u*)(X + (row >> 6) * 8192 + (pc >> 2) * 4096 + ((row >> 4) & 3) * 1024 + (row & 15) * 64 + (pc & 3) * 16) = o; }
    f32x4 ga[2][4], gb[2][4];
#pragma unroll
    for (int mt = 0; mt < 2; ++mt)
#pragma unroll
        for (int g = 0; g < 4; ++g) { const int c4 = hh * 64 + mt * 32 + 8 * g + 4 * hi; ga[mt][g] = *(const f32x4*)(gp0 + c4); gb[mt][g] = *(const f32x4*)(gp1 + c4); }
    f32x16 acc[2];
#pragma unroll
    for (int r = 0; r < 16; ++r) { acc[0][r] = 0.f; acc[1][r] = 0.f; }
#pragma unroll
    for (int ks = 0; ks < 8; ++ks) if (ks < lim) {
        const LAS unsigned char* blk = X + (ks >> 2) * 8192 + (ks & 3) * 1024;
        acc[0] = __builtin_amdgcn_mfma_f32_32x32x16_bf16(tr_frag(blk, lane), bw[ks], acc[0], 0, 0, 0);
        acc[1] = __builtin_amdgcn_mfma_f32_32x32x16_bf16(tr_frag(blk + 4096, lane), bw[ks], acc[1], 0, 0, 0);
    }
#pragma unroll
    for (int mt = 0; mt < 2; ++mt) {
#pragma unroll
        for (int g = 0; g < 4; ++g) { const int c4 = hh * 64 + mt * 32 + 8 * g + 4 * hi; const v2u u_ = uw[mt][g]; const f32x4 gc = (ga[mt][g] + gb[mt][g]) * rsm;
            const float o0 = __uint_as_float(u_.x << 16) * (acc[mt][4 * g + 0] + bb) * silu_f(gc[0]);
            const float o1 = __uint_as_float(u_.x & 0xffff0000u) * (acc[mt][4 * g + 1] + bb) * silu_f(gc[1]);
            const float o2 = __uint_as_float(u_.y << 16) * (acc[mt][4 * g + 2] + bb) * silu_f(gc[2]);
            const float o3 = __uint_as_float(u_.y & 0xffff0000u) * (acc[mt][4 * g + 3] + bb) * silu_f(gc[3]);
            v2u o; o.x = pk2(o0, o1); o.y = pk2(o2, o3);
            *(v2u*)(Y + m * DM + 768 + c4) = o; }
    }
}
__device__ __forceinline__ void gate_pair(Frame& F, const Args& A, const int L, const int ua, const int ub, const bool first) {
    unsigned char* ws = A.ws; const bf16* Z = (const bf16*)(ws + WS_Z);
    const int tid = F.tid, lane = F.lane, wid = F.wave, r32 = lane & 31, hi = lane >> 5, hf = wid >> 2, w4 = wid & 3, t4 = tid & 255;
    const int u = hf ? ub : ua; const bool act = u >= 0; const int uu = act ? u : 0, bh = uu / 31, i = 1 + uu % 31, b = bh >> 3, h = bh & 7;
    LAS unsigned char* lb = F.lds + hf * 12288;
    LAS unsigned char* kmh = lb; LAS unsigned char* kml = lb + 4096;
    LAS int* cnt = (LAS int*)(lb + 8192); LAS int* base = (LAS int*)(lb + 8448);
    const float* ksum = (const float*)(ws + WS_CTL + CTL_KSUM) + (size_t)L * 64 * 512;
    bf16x8 qr[2][4];
    if (act) {
#pragma unroll
        for (int k = 0; k < 8; ++k) { const int e = t4 + 256 * k, j = e >> 6, d = e & 63;
            const float v = (j < i) ? ksum[(size_t)(b * 32 + j) * 512 + h * 64 + d] : 0.f;
            const unsigned vh = f2bf(v), vl = f2bf(v - __uint_as_float(vh << 16));
            *(LAS bf16*)(kmh + (d >> 3) * 512 + j * 16 + (d & 7) * 2) = (bf16)vh; *(LAS bf16*)(kml + (d >> 3) * 512 + j * 16 + (d & 7) * 2) = (bf16)vl; }
        if (t4 < 33) cnt[t4] = 0;
#pragma unroll
        for (int t = 0; t < 2; ++t) { const bf16* qp = Z + (size_t)(b * SEQ + i * 256 + 64 * w4 + 32 * t + r32) * DIN + ZQ + h * 64 + hi * 8;
#pragma unroll
            for (int d0 = 0; d0 < 4; ++d0) qr[t][d0] = *(const bf16x8*)(qp + d0 * 16); }
    }
    __syncthreads();
    const int np = i < 3 ? i : 3;
    int jj[2][3], cc[2][3], pos[2][3];
#pragma unroll
    for (int t = 0; t < 2; ++t) { jj[t][0] = jj[t][1] = jj[t][2] = 0; cc[t][0] = cc[t][1] = cc[t][2] = 0; pos[t][0] = pos[t][1] = pos[t][2] = 0; }
    if (act) {
#pragma unroll
        for (int t = 0; t < 2; ++t) {
            f32x16 p;
#pragma unroll
            for (int r = 0; r < 16; ++r) p[r] = 0.f;
#pragma unroll
            for (int d0 = 0; d0 < 4; ++d0) {
                const bf16x8 ah = *(const LAS bf16x8*)(kmh + (2 * d0 + hi) * 512 + r32 * 16), al = *(const LAS bf16x8*)(kml + (2 * d0 + hi) * 512 + r32 * 16);
                p = __builtin_amdgcn_mfma_f32_32x32x16_bf16(ah, qr[t][d0], p, 0, 0, 0);
                p = __builtin_amdgcn_mfma_f32_32x32x16_bf16(al, qr[t][d0], p, 0, 0, 0);
            }
            float g0 = -INFINITY, g1 = -INFINITY, g2 = -INFINITY; int j0 = 0, j1 = 0, j2 = 0;
#define TOP3_INS(gv, jv) do { const float g_ = (gv); const int j_ = (jv); \
        if (g_ > g0) { g2 = g1; j2 = j1; g1 = g0; j1 = j0; g0 = g_; j0 = j_; } else if (g_ > g1) { g2 = g1; j2 = j1; g1 = g_; j1 = j_; } else if (g_ > g2) { g2 = g_; j2 = j_; } } while (0)
#pragma unroll
            for (int r = 0; r < 16; ++r) { const int j = crow(r, hi); TOP3_INS(j < i ? p[r] : -INFINITY, j); }
            {
                const auto a0 = __builtin_amdgcn_permlane32_swap(__float_as_uint(g0), __float_as_uint(g0), false, false), a1 = __builtin_amdgcn_permlane32_swap(__float_as_uint(g1), __float_as_uint(g1), false, false),
                           a2 = __builtin_amdgcn_permlane32_swap(__float_as_uint(g2), __float_as_uint(g2), false, false);
                const auto b0 = __builtin_amdgcn_permlane32_swap((unsigned)j0, (unsigned)j0, false, false), b1 = __builtin_amdgcn_permlane32_swap((unsigned)j1, (unsigned)j1, false, false),
                           b2 = __builtin_amdgcn_permlane32_swap((unsigned)j2, (unsigned)j2, false, false);
                const int sel = hi ? 0 : 1;
                const float h0 = __uint_as_float(a0[sel]), h1 = __uint_as_float(a1[sel]), h2 = __uint_as_float(a2[sel]); const int k0 = (int)b0[sel], k1 = (int)b1[sel], k2 = (int)b2[sel];
                TOP3_INS(h0, k0); TOP3_INS(h1, k1); TOP3_INS(h2, k2);
            }
#undef TOP3_INS
            const bool nq = 64 * w4 + 32 * t + r32 < 127;
            jj[t][0] = j0; jj[t][1] = j1; jj[t][2] = j2;
            cc[t][0] = (nq && j0 == i - 1) ? 32 : j0; cc[t][1] = (nq && j1 == i - 1) ? 32 : j1; cc[t][2] = (nq && j2 == i - 1) ? 32 : j2;
            if (hi == 0) {
                pos[t][0] = __hip_atomic_fetch_add(cnt + cc[t][0], 1, __ATOMIC_RELAXED, __HIP_MEMORY_SCOPE_WORKGROUP);
                if (np > 1) pos[t][1] = __hip_atomic_fetch_add(cnt + cc[t][1], 1, __ATOMIC_RELAXED, __HIP_MEMORY_SCOPE_WORKGROUP);
                if (np > 2) pos[t][2] = __hip_atomic_fetch_add(cnt + cc[t][2], 1, __ATOMIC_RELAXED, __HIP_MEMORY_SCOPE_WORKGROUP);
            }
        }
    }
    __syncthreads();
    if (act && t4 < i) base[t4] = first ? atomicAdd((int*)(ws + WS_CTL + CTL_NTOT) + L * 512 + bh * 32 + t4, cnt[t4]) : 0;
    if (act && t4 == 32) { base[32] = NEAR_OFF; if (first) ((int*)(ws + WS_CTL + CTL_NNEAR))[L * 512 + bh * 32 + i - 1] = cnt[32]; }
    __syncthreads();
    if (act && hi == 0 && first) {
        u16* Lg = (u16*)(ws + WS_LISTS) + (size_t)bh * 32 * 8192;
#pragma unroll
        for (int t = 0; t < 2; ++t) { const int tok = i * 256 + 64 * w4 + 32 * t + r32;
            Lg[(size_t)jj[t][0] * 8192 + base[cc[t][0]] + pos[t][0]] = (u16)tok;
            if (np > 1) Lg[(size_t)jj[t][1] * 8192 + base[cc[t][1]] + pos[t][1]] = (u16)(tok | (1 << 13));
            if (np > 2) Lg[(size_t)jj[t][2] * 8192 + base[cc[t][2]] + pos[t][2]] = (u16)(tok | (2 << 13)); }
    }
    __syncthreads();
}
__device__ __forceinline__ void mix_phase(Frame& F, const Args& A, const int L, const bool first = true) {
    for (int rp = 0; rp < REP_GATE; ++rp)
    for (int u = blockIdx.x; u < N_GATE_UNITS / 2; u += F.G) gate_pair(F, A, L, u, u + N_GATE_UNITS / 2, first && rp == 0);
    const int gwv = F.vcu * NWAVES + F.wave, NGW = F.G * NWAVES;
    for (int rp = 0; rp < REP_SGU; ++rp)
    for (int wu = gwv; wu < N_SGU_WU; wu += NGW) sgu_wave(F, A, L, wu);
    for (int rp = 0; rp < REP_POOL; ++rp)
    for (int wu = gwv; wu < N_POOL_WU; wu += NGW) pool_wave(F, A, L, wu);
    if (L == 0 && first) p0_prologue<1>(F, A);
    __syncthreads();
}
__device__ __forceinline__ void attn_wave_chunk(Frame& F, const Args& A, const int bh, const int j, const int c, const int ec, const bf16x8 (&qr)[4]) {
    unsigned char* ws = A.ws;
    const int lane = F.lane, wid = F.wave, r32 = lane & 31, hi = lane >> 5;
    LAS unsigned char* lds = F.lds; LAS float* bl = (LAS float*)(lds + A_BIAS);
    const int kbase = 256 * j;
    if (__all(((ec >> 20) & 1) == 0)) return;
    const int ntile = (c == 0) ? (wid >> 1) + 1 : 4;
    const bool nearb = (c != 1);
    float m = 0.f, l = 0.f; f32x16 o[2], negm;
#pragma unroll
    for (int r = 0; r < 16; ++r) { o[0][r] = 0.f; o[1][r] = 0.f; negm[r] = 0.f; }
    LAS float* wsf = (LAS float*)(lds + A_WSF) + wid * 64;
    const LAS unsigned char* kp0 = lds + A_K + hi * 1024 + r32 * 16;
    const LAS unsigned char* vp0 = lds + A_V + ((lane >> 4) & 1) * 32 + (lane & 3) * 8 + (4 * hi + ((lane & 15) >> 2)) * 64;
    if (c == 1) {
    bf16x8 kf[8];
#define AT_KLOAD(KT) do { _Pragma("unroll") for (int i = 0; i < 8; ++i) kf[i] = *(const LAS bf16x8*)(kp0 + (KT) * 8192 + (i >> 1) * 2048 + (i & 1) * 512); } while (0)
#define AT_SBAR() __builtin_amdgcn_sched_barrier(0)
#define AT_PIN(x) asm volatile("" : "+v"(x))
#define AT_ROWMAX(P0, P1, RM) do { asm volatile("s_nop 15\n\ts_nop 7" : "+v"(P0), "+v"(P1)); \
        float ma_ = max3f_(P0[0], P0[1], P1[0]), mb_ = max3f_(P0[2], P0[3], P1[1]); ma_ = max3f_(ma_, P1[2], P1[3]); \
        _Pragma("unroll") for (int r = 4; r < 16; r += 4) { ma_ = max3f_(ma_, P0[r], P0[r + 1]); mb_ = max3f_(mb_, P0[r + 2], P0[r + 3]); ma_ = max3f_(ma_, P1[r], P1[r + 1]); mb_ = max3f_(mb_, P1[r + 2], P1[r + 3]); } \
        RM = max3f_(ma_, mb_, mb_); \
        { auto rr_ = __builtin_amdgcn_permlane32_swap(__float_as_uint(RM), __float_as_uint(RM), false, false); RM = max3f_(__uint_as_float(rr_[0]), __uint_as_float(rr_[1]), __uint_as_float(rr_[1])); } } while (0)
    f32x16 pa0, pa1, pb0, pb1;
    AT_KLOAD(0);
    pa0 = negm; pa1 = negm;
#pragma unroll
    for (int d0 = 0; d0 < 4; ++d0) { pa0 = __builtin_amdgcn_mfma_f32_32x32x16_bf16(kf[2 * d0], qr[d0], pa0, 0, 0, 0); pa1 = __builtin_amdgcn_mfma_f32_32x32x16_bf16(kf[2 * d0 + 1], qr[d0], pa1, 0, 0, 0); }
    if (1 < ntile) AT_KLOAD(1);
    { float rm; AT_ROWMAX(pa0, pa1, rm); m = rm;
#pragma unroll
      for (int r = 0; r < 16; ++r) { pa0[r] = __builtin_amdgcn_exp2f(pa0[r] - rm); pa1[r] = __builtin_amdgcn_exp2f(pa1[r] - rm); negm[r] = -rm; } }
    s16x4 vlo[4], vhi[4]; v4u pw0, pw1, pw2, pw3; bool resc;
#define AT_PKW(P, B) cvtpk_s(P[B], P[B + 1])
#define AT_VFR(i) (bf16x8){vlo[i][0], vlo[i][1], vlo[i][2], vlo[i][3], vhi[i][0], vhi[i][1], vhi[i][2], vhi[i][3]}
#define AT_VRD(VP, i) do { vlo[(i) & 3] = vtr(VP + ((i) >> 2) * 4096 + ((i) & 3) * 1024); vhi[(i) & 3] = vtr(VP + ((i) >> 2) * 4096 + ((i) & 3) * 1024 + 512); } while (0)
#define AT_GAPA(MF, A0, A1, A2, A3, W0, W1, PW) do { MF; sacc += A0; sacc += A1; sacc += A2; sacc += A3; AT_PIN(sacc); W0; W1; AT_SBAR(); } while (0)
#define AT_GAPB(MF, X, B) do { MF; X[B] = __builtin_amdgcn_exp2f(X[B]); X[B + 1] = __builtin_amdgcn_exp2f(X[B + 1]); X[B + 2] = __builtin_amdgcn_exp2f(X[B + 2]); X[B + 3] = __builtin_amdgcn_exp2f(X[B + 3]); AT_PIN(X); AT_SBAR(); } while (0)
#define AT_PV(k, v, d) o[d] = __builtin_amdgcn_mfma_f32_32x32x16_bf16(__builtin_bit_cast(bf16x8, pw##k), AT_VFR((v) & 3), o[d], 0, 0, 0)
#define AT_STEP(C0, C1, P0, P1, T) do { AT_SBAR(); \
        const LAS unsigned char* vp_ = vp0 + ((T) - 1) * 8192; \
        C0 = negm; C1 = negm; \
        AT_VRD(vp_, 0); AT_SBAR(); float sacc = (P0[0] + P0[1]); \
        AT_GAPA(C0 = __builtin_amdgcn_mfma_f32_32x32x16_bf16(kf[0], qr[0], C0, 0, 0, 0), P0[2], P0[3], P0[4], P0[5],     pw0[0] = AT_PKW(P0, 0), pw0[1] = AT_PKW(P0, 2), pw0); \
        AT_GAPA(C1 = __builtin_amdgcn_mfma_f32_32x32x16_bf16(kf[1], qr[0], C1, 0, 0, 0), P0[6], P0[7], P0[8], P0[9],     pw0[2] = AT_PKW(P0, 4), pw0[3] = AT_PKW(P0, 6), pw0); \
        AT_VRD(vp_, 1); AT_SBAR(); AT_GAPA(C0 = __builtin_amdgcn_mfma_f32_32x32x16_bf16(kf[2], qr[1], C0, 0, 0, 0), P0[10], P0[11], P0[12], P0[13], pw1[0] = AT_PKW(P0, 8), pw1[1] = AT_PKW(P0, 10), pw1); \
        AT_GAPA(C1 = __builtin_amdgcn_mfma_f32_32x32x16_bf16(kf[3], qr[1], C1, 0, 0, 0), P0[14], P0[15], P1[0], P1[1],   pw1[2] = AT_PKW(P0, 12), pw1[3] = AT_PKW(P0, 14), pw1); \
        AT_VRD(vp_, 2); AT_SBAR(); AT_GAPA(C0 = __builtin_amdgcn_mfma_f32_32x32x16_bf16(kf[4], qr[2], C0, 0, 0, 0), P1[2], P1[3], P1[4], P1[5],     pw2[0] = AT_PKW(P1, 0), pw2[1] = AT_PKW(P1, 2), pw2); \
        AT_GAPA(C1 = __builtin_amdgcn_mfma_f32_32x32x16_bf16(kf[5], qr[2], C1, 0, 0, 0), P1[6], P1[7], P1[8], P1[9],     pw2[2] = AT_PKW(P1, 4), pw2[3] = AT_PKW(P1, 6), pw2); \
        AT_VRD(vp_, 3); AT_SBAR(); AT_GAPA(C0 = __builtin_amdgcn_mfma_f32_32x32x16_bf16(kf[6], qr[3], C0, 0, 0, 0), P1[10], P1[11], P1[12], P1[13], pw3[0] = AT_PKW(P1, 8), pw3[1] = AT_PKW(P1, 10), pw3); \
        AT_GAPA(C1 = __builtin_amdgcn_mfma_f32_32x32x16_bf16(kf[7], qr[3], C1, 0, 0, 0), P1[14], P1[15], 0.f, 0.f,       pw3[2] = AT_PKW(P1, 12), pw3[3] = AT_PKW(P1, 14), pw3); \
        l += sacc; \
        if ((T) + 1 < ntile) AT_KLOAD((T) + 1); \
        resc = false; \
        { float rm_; AT_ROWMAX(C0, C1, rm_); \
          if (__any(rm_ > ATT_THR)) { const float dl_ = __builtin_fmaxf(rm_, 0.f); m += dl_; \
              _Pragma("unroll") for (int r = 0; r < 16; ++r) { C0[r] -= dl_; C1[r] -= dl_; } \
              _Pragma("unroll") for (int r = 0; r < 16; ++r) negm[r] = -m; \
              const float f_ = __builtin_amdgcn_exp2f(-dl_); l *= f_; if (hi == 0) wsf[r32] = f_; resc = true; } } \
        AT_SBAR(); \
        AT_GAPB(AT_PV(0, 0, 0); AT_VRD(vp_, 4), C0, 0); AT_GAPB(AT_PV(1, 1, 0); AT_VRD(vp_, 5), C0, 4); AT_GAPB(AT_PV(2, 2, 0); AT_VRD(vp_, 6), C0, 8); AT_GAPB(AT_PV(3, 3, 0); AT_VRD(vp_, 7), C0, 12); \
        AT_GAPB(AT_PV(0, 4, 1), C1, 0); AT_GAPB(AT_PV(1, 5, 1), C1, 4); AT_GAPB(AT_PV(2, 6, 1), C1, 8); AT_GAPB(AT_PV(3, 7, 1), C1, 12); \
        if (resc) { _Pragma("unroll") for (int r = 0; r < 16; ++r) { const float fr_ = wsf[crow(r, hi)]; o[0][r] *= fr_; o[1][r] *= fr_; } }     \
    } while (0)
#define AT_DRAIN(P0, P1, T) do { const LAS unsigned char* vp_ = vp0 + (T) * 8192; \
        _Pragma("unroll") for (int i = 0; i < 4; ++i) AT_VRD(vp_, i); \
        float sacc = 0.f; _Pragma("unroll") for (int r = 0; r < 16; ++r) sacc += P0[r] + P1[r]; l += sacc; \
        pw0 = (v4u){AT_PKW(P0, 0), AT_PKW(P0, 2), AT_PKW(P0, 4), AT_PKW(P0, 6)}; pw1 = (v4u){AT_PKW(P0, 8), AT_PKW(P0, 10), AT_PKW(P0, 12), AT_PKW(P0, 14)}; \
        pw2 = (v4u){AT_PKW(P1, 0), AT_PKW(P1, 2), AT_PKW(P1, 4), AT_PKW(P1, 6)}; pw3 = (v4u){AT_PKW(P1, 8), AT_PKW(P1, 10), AT_PKW(P1, 12), AT_PKW(P1, 14)}; \
        AT_PV(0, 0, 0); AT_VRD(vp_, 4); AT_PV(1, 1, 0); AT_VRD(vp_, 5); AT_PV(2, 2, 0); AT_VRD(vp_, 6); AT_PV(3, 3, 0); AT_VRD(vp_, 7); AT_PV(0, 4, 1); AT_PV(1, 5, 1); AT_PV(2, 6, 1); AT_PV(3, 7, 1); } while (0)
    int t = 1;
#pragma unroll 1
    for (; t + 1 < ntile; t += 2) { AT_STEP(pb0, pb1, pa0, pa1, t); AT_STEP(pa0, pa1, pb0, pb1, t + 1); }
    if (t < ntile) { AT_STEP(pb0, pb1, pa0, pa1, t); AT_DRAIN(pb0, pb1, t); }
    else { AT_DRAIN(pa0, pa1, t - 1); }
#undef AT_DRAIN
#undef AT_STEP
#undef AT_PV
#undef AT_GAPB
#undef AT_GAPA
#undef AT_VRD
#undef AT_VFR
#undef AT_PKW
#undef AT_ROWMAX
#undef AT_PIN
#undef AT_SBAR
#undef AT_KLOAD
    } else {
    const int tq = ec & 0xffff; const float bfar = bl[0];
    bf16x8 kf[8];
#pragma unroll
    for (int i = 0; i < 8; ++i) kf[i] = *(const LAS bf16x8*)(kp0 + (i >> 1) * 2048 + (i & 1) * 512);
#pragma unroll
    for (int kt = 0; kt < 4; ++kt) if (kt < ntile) {
        f32x16 p0, p1;
        if (nearb) {
            const int dq = tq - (kbase + kt * 64);
            if (__all(dq - 63 >= 128)) {
                const float cb = bfar - m;
#pragma unroll
                for (int r = 0; r < 16; ++r) { p0[r] = cb; p1[r] = cb; }
            } else {
                const LAS float* rb = bl + (383 - dq + 4 * hi);
#pragma unroll
                for (int r = 0; r < 16; ++r) { p0[r] = rb[(r & 3) + 8 * (r >> 2)] - m; p1[r] = rb[(r & 3) + 8 * (r >> 2) + 32] - m; }
            }
#pragma unroll
            for (int d0 = 0; d0 < 4; ++d0) {
                p0 = __builtin_amdgcn_mfma_f32_32x32x16_bf16(kf[2 * d0], qr[d0], p0, 0, 0, 0);
                p1 = __builtin_amdgcn_mfma_f32_32x32x16_bf16(kf[2 * d0 + 1], qr[d0], p1, 0, 0, 0);
            }
        } else {
            p0 = __builtin_amdgcn_mfma_f32_32x32x16_bf16(kf[0], qr[0], negm, 0, 0, 0);
            p1 = __builtin_amdgcn_mfma_f32_32x32x16_bf16(kf[1], qr[0], negm, 0, 0, 0);
#pragma unroll
            for (int d0 = 1; d0 < 4; ++d0) {
                p0 = __builtin_amdgcn_mfma_f32_32x32x16_bf16(kf[2 * d0], qr[d0], p0, 0, 0, 0);
                p1 = __builtin_amdgcn_mfma_f32_32x32x16_bf16(kf[2 * d0 + 1], qr[d0], p1, 0, 0, 0);
            }
        }
        const LAS unsigned char* vp = vp0 + kt * 8192;
        s16x4 vlo[8], vhi[8];
#pragma unroll
        for (int i = 0; i < 8; ++i) { vlo[i] = vtr(vp + (i >> 2) * 4096 + (i & 3) * 1024); vhi[i] = vtr(vp + (i >> 2) * 4096 + (i & 3) * 1024 + 512); }
        if (kt + 1 < ntile) {
#pragma unroll
            for (int i = 0; i < 8; ++i) kf[i] = *(const LAS bf16x8*)(kp0 + (kt + 1) * 8192 + (i >> 1) * 2048 + (i & 1) * 512);
        }
        asm volatile("s_nop 15\n\ts_nop 7" : "+v"(p0), "+v"(p1));
        float ma = max3f_(p0[0], p0[1], p1[0]), mb = max3f_(p0[2], p0[3], p1[1]); ma = max3f_(ma, p1[2], p1[3]);
#pragma unroll
        for (int r = 4; r < 16; r += 4) { ma = max3f_(ma, p0[r], p0[r + 1]); mb = max3f_(mb, p0[r + 2], p0[r + 3]); ma = max3f_(ma, p1[r], p1[r + 1]); mb = max3f_(mb, p1[r + 2], p1[r + 3]); }
        float rm = max3f_(ma, mb, mb);
        { auto rr = __builtin_amdgcn_permlane32_swap(__float_as_uint(rm), __float_as_uint(rm), false, false); rm = max3f_(__uint_as_float(rr[0]), __uint_as_float(rr[1]), __uint_as_float(rr[1])); }
        if (kt == 0 || __any(rm > ATT_THR)) {
            const float dl = (kt == 0) ? rm : __builtin_fmaxf(rm, 0.f);
            m += dl;
#pragma unroll
            for (int r = 0; r < 16; ++r) { p0[r] -= dl; p1[r] -= dl; }
#pragma unroll
            for (int r = 0; r < 16; ++r) negm[r] = -m;
            if (kt > 0) {
                const float f = __builtin_amdgcn_exp2f(-dl); l *= f;
                if (hi == 0) wsf[r32] = f;
#pragma unroll
                for (int r = 0; r < 16; ++r) { const float fr_ = wsf[crow(r, hi)]; o[0][r] *= fr_; o[1][r] *= fr_; }
            }
        }
        float sacc = 0.f;
#pragma unroll
        for (int r = 0; r < 16; ++r) { p0[r] = __builtin_amdgcn_exp2f(p0[r]); p1[r] = __builtin_amdgcn_exp2f(p1[r]); sacc += p0[r] + p1[r]; }
        l += sacc;
        v4u pw0, pw1, pw2, pw3;
        pw0 = (v4u){cvtpk_s(p0[0], p0[1]), cvtpk_s(p0[2], p0[3]), cvtpk_s(p0[4], p0[5]), cvtpk_s(p0[6], p0[7])};
        pw1 = (v4u){cvtpk_s(p0[8], p0[9]), cvtpk_s(p0[10], p0[11]), cvtpk_s(p0[12], p0[13]), cvtpk_s(p0[14], p0[15])};
        pw2 = (v4u){cvtpk_s(p1[0], p1[1]), cvtpk_s(p1[2], p1[3]), cvtpk_s(p1[4], p1[5]), cvtpk_s(p1[6], p1[7])};
        pw3 = (v4u){cvtpk_s(p1[8], p1[9]), cvtpk_s(p1[10], p1[11]), cvtpk_s(p1[12], p1[13]), cvtpk_s(p1[14], p1[15])};
#define PKV(k) (bf16x8){vlo[k][0], vlo[k][1], vlo[k][2], vlo[k][3], vhi[k][0], vhi[k][1], vhi[k][2], vhi[k][3]}
#pragma unroll
        for (int d0 = 0; d0 < 2; ++d0) {
            o[d0] = __builtin_amdgcn_mfma_f32_32x32x16_bf16(__builtin_bit_cast(bf16x8, pw0), PKV(4 * d0 + 0), o[d0], 0, 0, 0);
            o[d0] = __builtin_amdgcn_mfma_f32_32x32x16_bf16(__builtin_bit_cast(bf16x8, pw1), PKV(4 * d0 + 1), o[d0], 0, 0, 0);
            o[d0] = __builtin_amdgcn_mfma_f32_32x32x16_bf16(__builtin_bit_cast(bf16x8, pw2), PKV(4 * d0 + 2), o[d0], 0, 0, 0);
            o[d0] = __builtin_amdgcn_mfma_f32_32x32x16_bf16(__builtin_bit_cast(bf16x8, pw3), PKV(4 * d0 + 3), o[d0], 0, 0, 0);
        }
#undef PKV
    }
    }
    if (!nearb) m += bl[0];
    const float lt = swap_add(l);
    if (hi == 0) wsf[32 + r32] = lt;
    LAS bf16* stg = (LAS bf16*)(lds + A_OST) + wid * 2048;
#pragma unroll
    for (int r = 0; r < 16; ++r) { const int orow = crow(r, hi); const float rli = __builtin_amdgcn_rcpf(wsf[32 + orow]);
        stg[orow * 64 + r32] = (bf16)f2bf(o[0][r] * rli); stg[orow * 64 + 32 + r32] = (bf16)f2bf(o[1][r] * rli); }
    bf16* OP = (bf16*)(ws + WS_OPART); float* LSE = (float*)(ws + WS_LSE);
    const int e = ((ec >> 20) & 1) ? ec : 0;
    if (hi == 0 && ((ec >> 20) & 1)) LSE[((size_t)bh * SEQ + (ec & 0xffff)) * 4 + ((ec >> 16) & 3)] = m + __builtin_amdgcn_logf(lt);
#pragma unroll
    for (int i = 0; i < 4; ++i) { const int row = i * 8 + (lane >> 3), ch = lane & 7; const int er = __shfl(e, row);
        const v4u v = *(const LAS v4u*)(stg + row * 64 + ch * 8);
        if ((er >> 20) & 1) *(v4u*)(OP + (((size_t)bh * SEQ + (er & 0xffff)) * 4 + ((er >> 16) & 3)) * 64 + ch * 8) = v; }
}
__device__ __forceinline__ void attn_phase(Frame& F, const Args& A, const int L) {
    unsigned char* ws = A.ws; const bf16* Z = (const bf16*)(ws + WS_Z);
    LAS unsigned char* lds = F.lds;
    LAS int* pref = (LAS int*)(lds + A_PREF); LAS int* nts = (LAS int*)(lds + A_NT); LAS int* ud = (LAS int*)(lds + A_UD);
    const int tid = F.tid, lane = F.lane, wid = F.wave, r32 = lane & 31, hi = lane >> 5;
    LAS int* nnr = (LAS int*)(lds + A_NN);
    {   const int n = ((const int*)(ws + WS_CTL + CTL_NTOT))[L * 512 + tid], nn = ((const int*)(ws + WS_CTL + CTL_NNEAR))[L * 512 + tid];
        nts[tid] = n; nnr[tid] = nn;
        if (tid == 0) pref[0] = 0;
        pref[1 + tid] = 1 + ((n + 255) >> 8) + (nn > 0 ? 1 : 0);
        __syncthreads();
        for (int off = 1; off < 512; off <<= 1) { const int t = (tid >= off) ? pref[1 + tid - off] : 0; __syncthreads(); pref[1 + tid] += t; __syncthreads(); }
    }
    const int U = pref[512];
    const int u0 = (int)(((long)F.vcu * U) / F.G), u1 = (int)(((long)(F.vcu + 1) * U) / F.G);
    int nU = u1 - u0; if (nU > 64) nU = 64;
    if (tid < nU) { const int u = u0 + tid; int lo = 0, hh = 511;
        while (lo < hh) { const int mid = (lo + hh + 1) >> 1; if (pref[mid] <= u) lo = mid; else hh = mid - 1; }
        const int c = u - pref[lo], nf = (nts[lo] + 255) >> 8; ud[tid] = (lo << 8) | ((c == 0 ? 0 : (c <= nf ? 1 : 2)) << 6) | (c == 0 ? 0 : (c <= nf ? c - 1 : 0)); }
    __syncthreads();
    const u16* LST = (const u16*)(ws + WS_LISTS);
#define AT_ERAW(k, R) do { const int d_ = ud[k], it_ = d_ >> 8, ty_ = (d_ >> 6) & 3, ci_ = d_ & 63; R = -1; \
        if (ty_ != 0) { const int g_ = (ty_ == 1 ? 256 * ci_ : NEAR_OFF) + 32 * wid + r32; const bool v_ = (ty_ == 1) ? (g_ < nts[it_]) : (g_ - NEAR_OFF < nnr[it_]); if (v_) R = (int)LST[(size_t)it_ * 8192 + g_]; } } while (0)
#define AT_EDEC(k, R, E) do { const int d_ = ud[k], ty_ = (d_ >> 6) & 3, j_ = (d_ >> 8) & 31; \
        if (ty_ == 0) E = (256 * j_ + 32 * wid + r32) | (3 << 16) | (1 << 20); \
        else E = (R >= 0) ? ((R & 8191) | ((R >> 13) << 16) | (1 << 20)) : (j_ < 31 ? 256 * j_ + 256 : 256 * j_); } while (0)
#define AT_QLOAD(k, E, Q) do { const int it_ = ud[k] >> 8, bh_ = it_ >> 5; const bf16* qp_ = Z + ((size_t)(bh_ >> 3) * SEQ + ((E) & 0xffff)) * DIN + ZQ + (bh_ & 7) * 64 + hi * 8; \
        _Pragma("unroll") for (int d0 = 0; d0 < 4; ++d0) Q[d0] = *(const bf16x8*)(qp_ + d0 * 16); } while (0)
#define AT_KVLOAD(it) do { const int bh_ = (it) >> 5, j_ = (it) & 31; const bf16* Zb_ = Z + (size_t)(bh_ >> 3) * SEQ * DIN + (bh_ & 7) * 64; \
        _Pragma("unroll") for (int k_ = 0; k_ < 4; ++k_) { kreg[k_] = *(const v4u*)(Zb_ + (size_t)(256 * j_ + 64 * k_ + lane) * DIN + ZK + wid * 8); \
            vreg[k_] = *(const v4u*)(Zb_ + (size_t)(256 * j_ + 64 * k_ + 16 * (wid & 3) + (lane >> 2)) * DIN + ZV + (wid >> 2) * 32 + (lane & 3) * 8); } } while (0)
    int e1 = 0, r2 = -1;
    if (nU > 0) { int r0; AT_ERAW(0, r0); AT_EDEC(0, r0, e1); }
    if (nU > 1) AT_ERAW(1, r2);
    int cur = -1;
    for (int k = 0; k < nU; ++k) {
        const int d = ud[k], item = __builtin_amdgcn_readfirstlane(d >> 8), c = __builtin_amdgcn_readfirstlane((d >> 6) & 3), bh = item >> 5, j = item & 31;
        const int ec = e1; bf16x8 qc[4];
        AT_QLOAD(k, ec, qc);
        if (k + 1 < nU) { AT_EDEC(k + 1, r2, e1); }
        if (k + 2 < nU) AT_ERAW(k + 2, r2);
        if (item != cur) {
            v4u kreg[4], vreg[4]; AT_KVLOAD(item);
            __syncthreads();
            if (tid < NREV) { const int dd = 383 - tid; ((LAS float*)(lds + A_BIAS))[tid] = dd < 0 ? -INFINITY : ((const float*)(ws + WS_BIAS2))[(bh & 7) * NBIAS + (dd < 128 ? dd : 128)]; }
#pragma unroll
            for (int k_ = 0; k_ < 4; ++k_) { *(LAS v4u*)(lds + A_K + k_ * 8192 + wid * 1024 + lane * 16) = kreg[k_]; *(LAS v4u*)(lds + A_V + k_ * 8192 + wid * 1024 + lane * 16) = vreg[k_]; }
            __syncthreads();
            cur = item;
        }
        attn_wave_chunk(F, A, bh, j, c, ec, qc);
    }
#undef AT_ERAW
#undef AT_EDEC
#undef AT_QLOAD
#undef AT_KVLOAD
    __syncthreads();
}
__device__ __forceinline__ void combine_phase(Frame& F, const Args& A) {
    unsigned char* ws = A.ws; const bf16* Z = (const bf16*)(ws + WS_Z); bf16* Y = (bf16*)(ws + WS_XN);
    const bf16* OP = (const bf16*)(ws + WS_OPART); const float* LSE = (const float*)(ws + WS_LSE);
    const int ch = F.tid & 7;
    for (int it = 0; it < (M * NH) / (F.G * 64); ++it) { const int g = (F.vcu * ((M * NH) / (F.G * 64)) + it) * 64 + (F.tid >> 3);
        const int mrow = g >> 3, h = g & 7, b = mrow >> 13, t = mrow & (SEQ - 1), own = t >> 8, np = own < 3 ? own : 3;
        const size_t pr = ((size_t)(b * NH + h) * SEQ + t) * 4;
        const f32x4 ls = *(const f32x4*)(LSE + pr);
        float mx = ls[3];
        if (np > 0) mx = __builtin_fmaxf(mx, ls[0]); if (np > 1) mx = __builtin_fmaxf(mx, ls[1]); if (np > 2) mx = __builtin_fmaxf(mx, ls[2]);
        float acc[8], wsum = 0.f;
#pragma unroll
        for (int i = 0; i < 8; ++i) acc[i] = 0.f;
#pragma unroll
        for (int s = 0; s < 4; ++s) {
            if (s == 3 || s < np) { const float w = __builtin_amdgcn_exp2f(ls[s] - mx); wsum += w; float f[8]; unpack8(*(const v4u*)(OP + (pr + s) * 64 + ch * 8), f);
#pragma unroll
                for (int i = 0; i < 8; ++i) acc[i] += w * f[i]; }
        }
        const float inv = 1.f / wsum; float gaf[8]; unpack8(*(const v4u*)(Z + (size_t)mrow * DIN + ZGA + h * 64 + ch * 8), gaf);
        v4u o; o.x = pk2(acc[0] * inv * silu_f(gaf[0]), acc[1] * inv * silu_f(gaf[1])); o.y = pk2(acc[2] * inv * silu_f(gaf[2]), acc[3] * inv * silu_f(gaf[3]));
        o.z = pk2(acc[4] * inv * silu_f(gaf[4]), acc[5] * inv * silu_f(gaf[5])); o.w = pk2(acc[6] * inv * silu_f(gaf[6]), acc[7] * inv * silu_f(gaf[7]));
        *(v4u*)(Y + (size_t)mrow * DM + h * 64 + ch * 8) = o;
    }
}
constexpr int N_PHASES = 13;
#define IN(k) (lo <= (k) && (k) < hi)
#define SEAM(k) do { if (IN(k) && IN((k) + 1)) { for (int rep_ = 0; rep_ < REP_BAR; ++rep_) xcd_barrier(bar); } } while (0)
template <int L> __device__ __forceinline__ void layer_phases(Frame& F, const Args& args, const XcdBarrier& bar, const int lo, const int hi) {
    unsigned char* ws = args.ws;
    constexpr int P = 1 + 6 * L;
    if (IN(P + 0)) {
        const bf16* Ain = (const bf16*)((unsigned char*)args.out + 32 * MiB);
        const bf16* Wt = (const bf16*)(ws + WS_WIN + L * WIN_BYTES);
        pg8::SchedP1 S1; S1.so.init(M, DIN_MAIN, F.G, (int)blockIdx.x); S1.Ain = (const char*)Ain; S1.Wt = (const char*)Wt; S1.Pb = (const char*)((const bf16*)(ws + WS_PB) + (size_t)L * M * DPLE);
        S1.Wp = (const char*)(ws + WS_WPLE + L * 512 * KiB); S1.G = F.G; S1.c = (int)blockIdx.x;
        pg8::EpiP1 E1{pg8::EpiZ{(bf16*)(ws + WS_Z), (const float*)(ws + WS_SSQ), (float*)(ws + WS_CTL + CTL_KSUM) + (size_t)L * 64 * 512, C2, DIN, (float*)(ws + WS_STATS)},
                      pg8::EpiPart{(float*)(ws + WS_GCPART), M}, pg8::EpiT{(bf16*)args.out}};
        pg8::gemm_phase_x<pg8::EpiP1, pg8::SchedP1, PG8_ALIGN>(F.lds + RING_OFF, S1, E1);
#if REP_GEMM1 > 1
        if (REPB) xcd_barrier(bar);
        pg8::gemm_phase_x<pg8::EpiP1, pg8::SchedP1, PG8_ALIGN>(F.lds + RING_OFF, S1, E1);
#endif
    }
    SEAM(P + 0);
    if (IN(P + 1)) { for (int rep = 0; rep < REP_MIX; ++rep) mix_phase(F, args, L, rep == 0); }
    SEAM(P + 1);
    if (IN(P + 2)) { for (int rep = 0; rep < REP_ATTN; ++rep) attn_phase(F, args, L); }
    SEAM(P + 2);
    if (IN(P + 3)) { for (int rep = 0; rep < REP_COMB; ++rep) combine_phase(F, args); }
    SEAM(P + 3);
    if (IN(P + 4)) {
        pg8::Gemm g{(const bf16*)(ws + WS_XN), (const bf16*)(ws + WS_WOUT + L * 2 * MiB), M, DM, DM, DM}; pg8::StaticOrder S; S.init(M, DM, F.G, (int)blockIdx.x);
        pg8::EpiRes<false> E{(const void*)((unsigned char*)args.out + 32 * MiB), (bf16*)(ws + WS_H1B)};
        pg8::gemm_phase<pg8::EpiRes<false>, pg8::StaticOrder, PG8_ALIGN, PG8_SP2>(F.lds + RING_OFF, g, S, E);
#if REP_OUT0 > 1
        pg8::gemm_phase<pg8::EpiRes<false>, pg8::StaticOrder, PG8_ALIGN, PG8_SP2>(F.lds + RING_OFF, g, S, E);
#endif
    }
    SEAM(P + 4);
    if (IN(P + 5)) {
        pg8::Gemm g{(const bf16*)(ws + WS_H1B), (const bf16*)(ws + WS_WGATE + L * 2 * MiB), M, DM, DM, DM}; pg8::StaticOrder S; S.init(M, DM, F.G, (int)blockIdx.x);
        if constexpr (L + 1 < NL) {
            pg8::EpiPle E{(const bf16*)args.out, (const bf16*)(ws + WS_H1B), (bf16*)((unsigned char*)args.out + 32 * MiB), (float*)(ws + WS_SSQ)};
            pg8::gemm_phase<pg8::EpiPle, pg8::StaticOrder, false, PG8_SP2>(F.lds + RING_OFF, g, S, E);
#if REP_SIG > 1
            pg8::gemm_phase<pg8::EpiPle, pg8::StaticOrder, false, PG8_SP2>(F.lds + RING_OFF, g, S, E);
#endif
        } else {
            pg8::EpiPleFinal E{(const bf16*)args.out, (const bf16*)(ws + WS_H1B), args.out, args.in[12], (float*)(ws + WS_SSQ), bar};
            pg8::gemm_phase<pg8::EpiPleFinal, pg8::StaticOrder, false, PG8_SP2>(F.lds + RING_OFF, g, S, E);
        }
    }
    SEAM(P + 5);
}
__global__ void __launch_bounds__(NWAVES * 64, 2) skel_fwd(Args args) {
    extern __shared__ __attribute__((aligned(16))) unsigned char lds[];
    Frame F;
    F.lds = (LAS unsigned char*)lds;
    F.MISC = (volatile LAS unsigned*)(F.lds + MISC_OFF);
    F.tid = threadIdx.x; F.lane = F.tid & 63; F.wave = __builtin_amdgcn_readfirstlane(F.tid >> 6);
    F.G = gridDim.x; { const int bx = blockIdx.x; F.vcu = (F.G % 8 == 0) ? (bx % 8) * (F.G / 8) + bx / 8 : bx; }
    F.ctl = (gu32*)(args.ws + WS_CTL);
    for (int u = F.tid; u < (LDS_BYTES - LDSCTL_OFF) / 4; u += NWAVES * 64) ((LAS unsigned*)(F.lds + LDSCTL_OFF))[u] = 0u;
    __syncthreads();
    XcdBarrier bar = xcd_barrier_post((unsigned*)(F.ctl + CW_BAR) + args.li * XCD_BAR_WORDS, F.MISC + 8);
    const int lo = args.ph_lo, hi = args.ph_hi;
    if (IN(0)) { for (int rep = 0; rep < REP_PRO; ++rep) p0_prologue<0>(F, args); }
    SEAM(0);
    layer_phases<0>(F, args, bar, lo, hi);
    layer_phases<1>(F, args, bar, lo, hi);
}
extern "C" void kernel_launch(void* const* d_in, const int* in_sizes, int n_in, void* d_out, int out_size, void* d_ws, size_t ws_size, hipStream_t stream) {
    static int grid = 0;
    if (grid == 0) {
        if (n_in != 13 || in_sizes[0] != M * DM || out_size != M * DM || ws_size < WS_END) { fprintf(stderr, "kernel_launch: unexpected shapes: n_in %d in0 %d out %d ws %zu (need %zu)\n", n_in, n_in > 0 ? in_sizes[0] : -1, out_size, ws_size, (size_t)WS_END); grid = -1; return; }
        int dev = 0, cus = 0, per_cu = 0;
        if (hipGetDevice(&dev) != hipSuccess || hipDeviceGetAttribute(&cus, hipDeviceAttributeMultiprocessorCount, dev) != hipSuccess) { grid = -1; return; }
        if (hipFuncSetAttribute((const void*)skel_fwd, hipFuncAttributeMaxDynamicSharedMemorySize, LDS_BYTES) != hipSuccess) { fprintf(stderr, "kernel_launch: hipFuncSetAttribute failed\n"); grid = -1; return; }
        if (hipOccupancyMaxActiveBlocksPerMultiprocessor(&per_cu, (const void*)skel_fwd, NWAVES * 64, LDS_BYTES) != hipSuccess || per_cu < 1) fprintf(stderr, "kernel_launch: occupancy query reports %d\n", per_cu);
        (void)hipGetLastError();
        grid = cus;
        if (grid != 256) fprintf(stderr, "kernel_launch: %d CUs; this kernel needs 256\n", grid);
    }
    if (grid < 0) return;
    (void)hipMemsetAsync((char*)d_ws + WS_CTL, 0, CTL_ZERO_BYTES, stream);
    Args a{};
    for (int i = 0; i < 13; ++i) a.in[i] = (const float*)d_in[i];
    a.out = (float*)d_out; a.ws = (unsigned char*)d_ws;
    a.ph_lo = 0; a.ph_hi = N_PHASES; a.li = 0;
#ifdef PROBE_K
    a.ph_hi = PROBE_K;
    hipLaunchKernelGGL(skel_fwd, dim3(grid), dim3(NWAVES * 64), LDS_BYTES, stream, a);
    (void)hipMemsetAsync((char*)d_ws + WS_CTL, 0, CTL_ZERO_BYTES, stream);
    a.ph_hi = N_PHASES;
#endif
    hipLaunchKernelGGL(skel_fwd, dim3(grid), dim3(NWAVES * 64), LDS_BYTES, stream, a);
}
```

```cpp
#include <hip/hip_runtime.h>
#include <cstdio>
#include <cstdint>
namespace pg8 {
#define PG8_LAS __attribute__((address_space(3)))
typedef unsigned short bf16_t;
typedef short bf16x8 __attribute__((ext_vector_type(8)));
typedef float f32x4 __attribute__((ext_vector_type(4)));
typedef unsigned u32x4 __attribute__((ext_vector_type(4)));
constexpr int BM = 256, BK = 64, HALF = 128, HTB = HALF * BK * 2  , STAGE_BYTES = 8 * HTB, NXCD = 8, WGM = 8;

__host__ __device__ __forceinline__ int lds_byte(int r, int c) { const int st = (r >> 4) * 2 + (c >> 5), rr = r & 15, cc = c & 31, ob = rr * 64 + cc * 2; return st * 1024 + (ob ^ (((ob >> 9) & 1) << 5)); }
__host__ __device__ __forceinline__ void stage_rc(int b, int& R, int& C) { const int st = b / 1024, sb = b % 1024, swz = sb ^ (((sb >> 9) & 1) << 5); R = (st >> 1) * 16 + swz / 64; C = (st & 1) * 32 + (swz % 64) / 2; }
__host__ __device__ __forceinline__ int perm32(int rho) { const int n = rho >> 4, i = rho & 15; return 8 * (i >> 2) + 4 * n + (i & 3); }

struct Unit { int pm, pn; };
struct UnitX { int pm, pn, kind, nt, ldsel; const char* A; const char* B; };
struct Gemm { const bf16_t* A; const bf16_t* Bt; int M, N, K, ld; };

struct StaticOrder {
    int nM, nN, nwg, G, c;
    __host__ __device__ void init(int M, int N, int G_, int c_) { nM = M / BM; nN = N / BM; nwg = nM * nN; G = G_; c = c_; }
    __host__ __device__ bool next(int i, Unit& u) const {
        const long L = (long)i * G + c; if (L >= nwg) return false;
        int wgid = (int)L; { const int q = nwg / NXCD, r = nwg % NXCD, xcd = wgid % NXCD, off = wgid / NXCD; wgid = (xcd < r ? xcd * (q + 1) : r * (q + 1) + (xcd - r) * q) + off; }
        const int nig = WGM * nN, gid = wgid / nig, fm = gid * WGM, gsz = (nM - fm) < WGM ? (nM - fm) : WGM;
        u.pm = fm + ((wgid % nig) % gsz); u.pn = (wgid % nig) / gsz; return true;
    }
    __device__ __forceinline__ void a_ready(const Unit&) const {}
    __device__ __forceinline__ void done(const Unit&) const {}
};

typedef float f32x2_t __attribute__((ext_vector_type(2))); typedef __bf16 bf16x2_t __attribute__((ext_vector_type(2)));
__device__ __forceinline__ unsigned cvt_pk_bf16(float lo, float hi) { f32x2_t v = {lo, hi}; bf16x2_t b = __builtin_convertvector(v, bf16x2_t); return __builtin_bit_cast(unsigned, b); }
__device__ __forceinline__ float bf_lo(unsigned w) { return __uint_as_float(w << 16); }
__device__ __forceinline__ float bf_hi(unsigned w) { return __uint_as_float(w & 0xffff0000u); }
typedef unsigned u32x2 __attribute__((ext_vector_type(2)));

struct EpiZ {
    static constexpr bool PERM = true, AFTER_DRAIN = false;
    bf16_t* Z; const float* ssq; float* ksum; float qscale; int ldz; float* vstat;
    __device__ __forceinline__ void operator()(const f32x4 (&acc)[2][2][4][2], const Unit& u, int wr, int wc, int fr, int fq) const {
        const int row0 = u.pm * BM + wr * 64 + fr, col0 = u.pn * BM + wc * 32 + 8 * fq;
        const float sc = (u.pn < 2) ? qscale : 1.f;
        const bool ktile = (u.pn == 2 || u.pn == 3), vtile = (u.pn == 11);
        float cs[2][8];
#pragma unroll
        for (int bj = 0; bj < 2; ++bj)
#pragma unroll
            for (int i = 0; i < 8; ++i) cs[bj][i] = 0.f;
#pragma unroll
        for (int ai = 0; ai < 2; ++ai)
#pragma unroll
            for (int m = 0; m < 4; ++m) {
                const int row = row0 + ai * HALF + m * 16;
                const f32x4 s4 = *(const f32x4*)(ssq + (size_t)row * 4);
                const float rs = __builtin_amdgcn_rsqf(((s4[0] + s4[1]) + (s4[2] + s4[3])) * (1.0f / 1024.0f) + 1e-6f) * sc;
                bf16_t* rowp = Z + (size_t)row * ldz + col0;
                float vs = 0.f, vq = 0.f;
#pragma unroll
                for (int bj = 0; bj < 2; ++bj) {
                    const f32x4 v0 = acc[ai][bj][m][0] * rs, v1 = acc[ai][bj][m][1] * rs;
                    if (vtile) { vs += (v0[0] + v0[1]) + (v0[2] + v0[3]) + (v1[0] + v1[1]) + (v1[2] + v1[3]);
                                 vq += (v0[0] * v0[0] + v0[1] * v0[1]) + (v0[2] * v0[2] + v0[3] * v0[3]) + (v1[0] * v1[0] + v1[1] * v1[1]) + (v1[2] * v1[2] + v1[3] * v1[3]); }
                    u32x4 w; w.x = cvt_pk_bf16(v0[0], v0[1]); w.y = cvt_pk_bf16(v0[2], v0[3]); w.z = cvt_pk_bf16(v1[0], v1[1]); w.w = cvt_pk_bf16(v1[2], v1[3]);
                    *(u32x4*)(rowp + bj * HALF) = w;
                    if (ktile) {
#pragma unroll
                        for (int i = 0; i < 4; ++i) { cs[bj][i] += v0[i]; cs[bj][4 + i] += v1[i]; }
                    }
                }
                if (vtile) { vs += __shfl_xor(vs, 16); vs += __shfl_xor(vs, 32); vq += __shfl_xor(vq, 16); vq += __shfl_xor(vq, 32);
                             if (fq == 0) { typedef float f2_ __attribute__((ext_vector_type(2))); *(f2_*)(vstat + ((size_t)row * 4 + wc) * 2) = (f2_){vs, vq}; } }
            }
        if (ktile) {
#pragma unroll
            for (int bj = 0; bj < 2; ++bj)
#pragma unroll
                for (int i = 0; i < 8; ++i) {
                    float v = cs[bj][i];
                    v += __shfl_xor(v, 1); v += __shfl_xor(v, 2); v += __shfl_xor(v, 4); v += __shfl_xor(v, 8);
                    if (fr == 0) atomicAdd(ksum + (size_t)u.pm * 512 + (u.pn - 2) * 256 + bj * HALF + wc * 32 + 8 * fq + i, v);
                }
        }
    }
};
template <bool BASE_F32> struct EpiRes {
    static constexpr bool PERM = true, AFTER_DRAIN = false;
    const void* base; bf16_t* hb;
    __device__ __forceinline__ void operator()(const f32x4 (&acc)[2][2][4][2], const Unit& u, int wr, int wc, int fr, int fq) const {
        const int row0 = u.pm * BM + wr * 64 + fr, col0 = u.pn * BM + wc * 32 + 8 * fq;
        static_assert(!BASE_F32, "bf16 residual stream only");
#pragma unroll
        for (int ai = 0; ai < 2; ++ai) {
            u32x4 bw[4][2];
#pragma unroll
            for (int m = 0; m < 4; ++m)
#pragma unroll
                for (int bj = 0; bj < 2; ++bj) bw[m][bj] = *(const u32x4*)((const bf16_t*)base + (size_t)(row0 + ai * HALF + m * 16) * 1024 + col0 + bj * HALF);
            asm volatile("" ::: "memory");
#pragma unroll
            for (int m = 0; m < 4; ++m) {
                const size_t off = (size_t)(row0 + ai * HALF + m * 16) * 1024 + col0;
#pragma unroll
                for (int bj = 0; bj < 2; ++bj) {
                    const u32x4 w0 = bw[m][bj];
                    const f32x4 b0 = (f32x4){bf_lo(w0.x), bf_hi(w0.x), bf_lo(w0.y), bf_hi(w0.y)}, b1 = (f32x4){bf_lo(w0.z), bf_hi(w0.z), bf_lo(w0.w), bf_hi(w0.w)};
                    const f32x4 o0 = b0 + acc[ai][bj][m][0], o1 = b1 + acc[ai][bj][m][1];
                    u32x4 w; w.x = cvt_pk_bf16(o0[0], o0[1]); w.y = cvt_pk_bf16(o0[2], o0[3]); w.z = cvt_pk_bf16(o1[0], o1[1]); w.w = cvt_pk_bf16(o1[2], o1[3]);
                    *(u32x4*)(hb + off + bj * HALF) = w;
                }
            }
        }
    }
};
struct EpiResAcc {
    static constexpr bool PERM = true, AFTER_DRAIN = false;
    const bf16_t* base; bf16_t* hb;
    __device__ __forceinline__ void addbase(f32x4 (&acc)[2][2][4][2], const Unit& u) const {
        const int tid = threadIdx.x, wid = tid >> 6, lane = tid & 63, wr = wid >> 2, wc = wid & 3, fr = lane & 15, fq = lane >> 4;
        const int row0 = u.pm * BM + wr * 64 + fr, col0 = u.pn * BM + wc * 32 + 8 * fq;
#pragma unroll
        for (int ai = 0; ai < 2; ++ai) {
            u32x4 bw[4][2];
#pragma unroll
            for (int m = 0; m < 4; ++m)
#pragma unroll
                for (int bj = 0; bj < 2; ++bj) bw[m][bj] = *(const u32x4*)(base + (size_t)(row0 + ai * HALF + m * 16) * 1024 + col0 + bj * HALF);
#pragma unroll
            for (int m = 0; m < 4; ++m)
#pragma unroll
                for (int bj = 0; bj < 2; ++bj) { const u32x4 w = bw[m][bj];
                    acc[ai][bj][m][0] += (f32x4){bf_lo(w.x), bf_hi(w.x), bf_lo(w.y), bf_hi(w.y)}; acc[ai][bj][m][1] += (f32x4){bf_lo(w.z), bf_hi(w.z), bf_lo(w.w), bf_hi(w.w)}; }
        }
    }
    __device__ __forceinline__ void operator()(const f32x4 (&acc)[2][2][4][2], const Unit& u, int wr, int wc, int fr, int fq) const {
        const int row0 = u.pm * BM + wr * 64 + fr, col0 = u.pn * BM + wc * 32 + 8 * fq;
#pragma unroll
        for (int ai = 0; ai < 2; ++ai)
#pragma unroll
            for (int m = 0; m < 4; ++m)
#pragma unroll
                for (int bj = 0; bj < 2; ++bj) { const f32x4 o0 = acc[ai][bj][m][0], o1 = acc[ai][bj][m][1];
                    u32x4 w; w.x = cvt_pk_bf16(o0[0], o0[1]); w.y = cvt_pk_bf16(o0[2], o0[3]); w.z = cvt_pk_bf16(o1[0], o1[1]); w.w = cvt_pk_bf16(o1[2], o1[3]);
                    *(u32x4*)(hb + (size_t)(row0 + ai * HALF + m * 16) * 1024 + col0 + bj * HALF) = w; }
    }
};
struct EpiT {
    static constexpr bool PERM = true, AFTER_DRAIN = false;
    bf16_t* T;
    __device__ __forceinline__ void operator()(const f32x4 (&acc)[2][2][4][2], const Unit& u, int wr, int wc, int fr, int fq) const {
        const int row0 = u.pm * BM + wr * 64 + fr, col0 = u.pn * BM + wc * 32 + 8 * fq;
#pragma unroll
        for (int ai = 0; ai < 2; ++ai)
#pragma unroll
            for (int m = 0; m < 4; ++m) {
                bf16_t* rowp = T + (size_t)(row0 + ai * HALF + m * 16) * 1024 + col0;
#pragma unroll
                for (int bj = 0; bj < 2; ++bj) {
                    const f32x4 v0 = acc[ai][bj][m][0], v1 = acc[ai][bj][m][1];
                    u32x4 w; w.x = cvt_pk_bf16(v0[0], v0[1]); w.y = cvt_pk_bf16(v0[2], v0[3]); w.z = cvt_pk_bf16(v1[0], v1[1]); w.w = cvt_pk_bf16(v1[2], v1[3]);
                    *(u32x4*)(rowp + bj * HALF) = w;
                }
            }
    }
};
struct EpiPart {
    static constexpr bool PERM = true, AFTER_DRAIN = false;
    float* out; int rows;
    __device__ __forceinline__ void operator()(const f32x4 (&acc)[2][2][4][2], const Unit& u, int wr, int wc, int fr, int fq) const {
        const int col0 = wc * 32 + 8 * fq; float* base = out + (size_t)u.pn * rows * 256;
#pragma unroll
        for (int ai = 0; ai < 2; ++ai)
#pragma unroll
            for (int m = 0; m < 4; ++m) {
                float* rowp = base + (size_t)(u.pm * BM + ai * HALF + wr * 64 + m * 16 + fr) * 256 + col0;
#pragma unroll
                for (int bj = 0; bj < 2; ++bj) { *(f32x4*)(rowp + bj * HALF) = acc[ai][bj][m][0]; *(f32x4*)(rowp + bj * HALF + 4) = acc[ai][bj][m][1]; }
            }
    }
};
struct OneUnit {
    int pm, pn; bool has;
    __device__ __forceinline__ bool next(int i, Unit& u) const { if (i > 0 || !has) return false; u.pm = pm; u.pn = pn; return true; }
    __device__ __forceinline__ void a_ready(const Unit&) const {}
    __device__ __forceinline__ void done(const Unit&) const {}
};
struct IdleOrder {
    int G, c;
    __device__ __forceinline__ bool next(int i, Unit& u) const { const int h = G / 2; if (c < h) return false; const int L = i * h + (c - h); if (L >= 256) return false; u.pm = L >> 2; u.pn = L & 3; return true; }
    __device__ __forceinline__ void a_ready(const Unit&) const {}
    __device__ __forceinline__ void done(const Unit&) const {}
};
struct EpiP1 {
    static constexpr bool PERM = true, AFTER_DRAIN = false;
    EpiZ z; EpiPart h; EpiT t;
    __device__ __forceinline__ void operator()(const f32x4 (&acc)[2][2][4][2], const UnitX& u, int wr, int wc, int fr, int fq) const {
        const Unit uu{u.pm, u.pn};
        if (u.kind == 0) z(acc, uu, wr, wc, fr, fq); else if (u.kind == 1) h(acc, uu, wr, wc, fr, fq); else t(acc, uu, wr, wc, fr, fq);
    }
};
struct SchedP1 {
    StaticOrder so; const char* Ain; const char* Wt; const char* Pb; const char* Wp; int G, c;
    __device__ __forceinline__ bool next(int i, UnitX& u) const {
        constexpr size_t TS = (size_t)256 * 1024 * 2, TQ = (size_t)256 * 256 * 2;
        const int hG = G / 2; int mi = -1, xi = -1;
        if (c < hG) { const int xp = ((c >> 1) & 1) ? 2 : 0;
            if (i == xp) xi = 0; else mi = i < xp ? i : i - 1; }
        else { const int x0 = (c & 1) ? 0 : 1, x1 = (c & 1) ? 2 : 3;
            if (i == x0) xi = 0; else if (i == x1) xi = 1; else mi = i - (i > x0 ? 1 : 0) - (i > x1 ? 1 : 0); }
        if (mi >= 0) { if (mi > 2) return false; Unit q; if (!so.next(mi, q)) return false; u.pm = q.pm; u.pn = q.pn; u.kind = 0; u.nt = 16; u.ldsel = 0; u.A = Ain + q.pm * TS; u.B = Wt + q.pn * TS; return true; }
        if (c < hG) { const int pm = c >> 1, kh = c & 1;
            u.pm = pm; u.pn = kh; u.kind = 1; u.nt = 8; u.ldsel = 0; u.A = Ain + pm * TS + kh * 1024; u.B = Wt + 12 * TS + kh * 1024; return true; }
        const int L = xi * hG + (c - hG); if (L >= 256) return false;
        u.pm = L >> 2; u.pn = L & 3; u.kind = 2; u.nt = 4; u.ldsel = 1; u.A = Pb + (L >> 2) * TQ; u.B = Wp + (L & 3) * TQ; return true;
    }
};
struct EpiPle {
    static constexpr bool PERM = true, AFTER_DRAIN = true;
    const bf16_t* T; const bf16_t* h1; bf16_t* xs; float* ssq;
    __device__ __forceinline__ void fused(f32x4 (&acc)[2][2][4][2], const Unit& u, int wr, int wc, int fr, int fq, PG8_LAS unsigned char* lds, int wid, int lane) const {
        PG8_LAS float* P = (PG8_LAS float*)lds;
        const int col0 = u.pn * BM + wc * 32 + 8 * fq;
#pragma unroll
        for (int ai = 0; ai < 2; ++ai)
#pragma unroll
            for (int mp = 0; mp < 2; ++mp) {
                u32x4 twv[2][2], hwv[2][2];
#pragma unroll
                for (int mi = 0; mi < 2; ++mi) { const int rl = ai * HALF + wr * 64 + (2 * mp + mi) * 16 + fr; const size_t off = (size_t)(u.pm * BM + rl) * 1024 + col0;
#pragma unroll
                    for (int bj = 0; bj < 2; ++bj) { twv[mi][bj] = *(const u32x4*)(T + off + bj * HALF); hwv[mi][bj] = *(const u32x4*)(h1 + off + bj * HALF); } }
                asm volatile("" ::: "memory");
#pragma unroll
                for (int mi = 0; mi < 2; ++mi) { const int m = 2 * mp + mi;
                const int rl = ai * HALF + wr * 64 + m * 16 + fr;
                const size_t off = (size_t)(u.pm * BM + rl) * 1024 + col0;
                float q = 0.f;
#pragma unroll
                for (int bj = 0; bj < 2; ++bj) {
                    const u32x4 tw = twv[mi][bj], hw = hwv[mi][bj];
                    const f32x4 t0 = (f32x4){bf_lo(tw.x), bf_hi(tw.x), bf_lo(tw.y), bf_hi(tw.y)}, t1 = (f32x4){bf_lo(tw.z), bf_hi(tw.z), bf_lo(tw.w), bf_hi(tw.w)};
                    const f32x4 h0 = (f32x4){bf_lo(hw.x), bf_hi(hw.x), bf_lo(hw.y), bf_hi(hw.y)}, h1v = (f32x4){bf_lo(hw.z), bf_hi(hw.z), bf_lo(hw.w), bf_hi(hw.w)};
                    f32x4 s0 = acc[ai][bj][m][0], s1 = acc[ai][bj][m][1];
#pragma unroll
                    for (int i = 0; i < 4; ++i) { s0[i] = __builtin_amdgcn_rcpf(1.f + __expf(-s0[i])); s1[i] = __builtin_amdgcn_rcpf(1.f + __expf(-s1[i])); }
                    const f32x4 o0 = h0 + t0 * s0, o1 = h1v + t1 * s1;
                    q += (o0[0] * o0[0] + o0[1] * o0[1]) + (o0[2] * o0[2] + o0[3] * o0[3]) + (o1[0] * o1[0] + o1[1] * o1[1]) + (o1[2] * o1[2] + o1[3] * o1[3]);
                    u32x4 w; w.x = cvt_pk_bf16(o0[0], o0[1]); w.y = cvt_pk_bf16(o0[2], o0[3]); w.z = cvt_pk_bf16(o1[0], o1[1]); w.w = cvt_pk_bf16(o1[2], o1[3]); *(u32x4*)(xs + off + bj * HALF) = w;
                }
                q += __shfl_xor(q, 16); q += __shfl_xor(q, 32);
                if (fq == 0) P[rl * 4 + wc] = q;
                }
                asm volatile("" ::: "memory");
            }
        asm volatile("s_waitcnt lgkmcnt(0)" ::: "memory"); __builtin_amdgcn_s_barrier(); asm volatile("" ::: "memory");
        const int t = wid * 64 + lane;
        if (t < 256) { const float s = (P[t * 4 + 0] + P[t * 4 + 1]) + (P[t * 4 + 2] + P[t * 4 + 3]); ssq[(size_t)(u.pm * BM + t) * 4 + u.pn] = s; }
        asm volatile("s_waitcnt lgkmcnt(0)" ::: "memory"); __builtin_amdgcn_s_barrier(); asm volatile("" ::: "memory");
    }
};

template <class Epi, class Sched, bool ALIGN_EPI = false, bool SP2 = false>
__device__ __forceinline__ void gemm_phase(PG8_LAS unsigned char* lds, const Gemm g, const Sched& S, const Epi& E) {
    const int tid = threadIdx.x, wid = __builtin_amdgcn_readfirstlane(tid >> 6), lane = tid & 63, wr = wid >> 2, wc = wid & 3, fr = lane & 15, fq = lane >> 4;
    const int K = g.K, LD = g.ld, nt = K / BK;
    unsigned voffA[2], voffB[2];
#pragma unroll
    for (int i = 0; i < 2; ++i) { int R, C; stage_rc(tid * 16 + i * 8192, R, C); const int Rb = Epi::PERM ? ((R & ~31) + perm32(R & 31)) : R;
        voffA[i] = (unsigned)(R * LD + C) * 2u; voffB[i] = (unsigned)(Rb * LD + C) * 2u; }
    const size_t kstep = (size_t)(BK * 2);
    const size_t hstep = (size_t)HALF * LD * 2;
    const size_t tstep = 2 * hstep;
    const unsigned ldsw = (unsigned)wid * 1024u;
    const int aoff = lds_byte(wr * 64 + fr, fq * 8), boff = lds_byte(wc * 32 + fr, fq * 8);
#define PG8_SA(b, h) (((b) * 2 + (h)) * HTB)
#define PG8_SB(b, h) ((4 + (b) * 2 + (h)) * HTB)
#define PG8_STAGE(bufoff, gbase, voff) do { _Pragma("unroll") for (int _i = 0; _i < 2; ++_i) \
        __builtin_amdgcn_global_load_lds((const unsigned*)((const char*)(gbase) + (voff)[_i]), (PG8_LAS unsigned*)(lds + (bufoff) + ldsw + _i * 8192), 16, 0, 0); } while (0)
#define PG8_LDA(dst, b, h) do { _Pragma("unroll") for (int m = 0; m < 4; ++m) _Pragma("unroll") for (int k = 0; k < 2; ++k) dst[m][k] = *(const PG8_LAS bf16x8*)(lds + PG8_SA(b, h) + aoff + m * 2048 + k * 1024); } while (0)
#define PG8_LDB(dst, b, h) do { _Pragma("unroll") for (int n = 0; n < 2; ++n) _Pragma("unroll") for (int k = 0; k < 2; ++k) dst[n][k] = *(const PG8_LAS bf16x8*)(lds + PG8_SB(b, h) + boff + n * 2048 + k * 1024); } while (0)
#define PG8_MMA(ai, bj, At, Bt) do { __builtin_amdgcn_s_setprio(1); _Pragma("unroll") for (int m = 0; m < 4; ++m) _Pragma("unroll") for (int n = 0; n < 2; ++n) _Pragma("unroll") for (int k = 0; k < 2; ++k) \
        acc[ai][bj][m][n] = __builtin_amdgcn_mfma_f32_16x16x32_bf16(Bt[n][k], At[m][k], acc[ai][bj][m][n], 0, 0, 0); __builtin_amdgcn_s_setprio(0); } while (0)
#define PG8_WAIT_V(n) asm volatile("s_waitcnt vmcnt(" #n ")" ::: "memory")
#define PG8_WAIT_L(n) asm volatile("s_waitcnt lgkmcnt(" #n ")" ::: "memory")
#define PG8_BAR __builtin_amdgcn_s_barrier()
#define PG8_SCHED __builtin_amdgcn_sched_barrier(0)
    Unit cur, nxt; int ui = 0;
    if (!S.next(0, cur)) return;
    f32x4 acc[2][2][4][2];
#pragma unroll
    for (int a = 0; a < 2; ++a)
#pragma unroll
        for (int b = 0; b < 2; ++b)
#pragma unroll
            for (int m = 0; m < 4; ++m)
#pragma unroll
                for (int n = 0; n < 2; ++n) acc[a][b][m][n] = (f32x4){0.f, 0.f, 0.f, 0.f};
    bf16x8 At[4][2], B0[2][2], B1[2][2];
    const char* cA = (const char*)g.A + (size_t)cur.pm * tstep; const char* cB = (const char*)g.Bt + (size_t)cur.pn * tstep;
    S.a_ready(cur);
    if constexpr (SP2) {
        PG8_STAGE(PG8_SB(0, 0), cB, voffB); PG8_STAGE(PG8_SB(0, 1), cB + hstep, voffB); PG8_STAGE(PG8_SA(0, 0), cA, voffA); PG8_STAGE(PG8_SA(0, 1), cA + hstep, voffA);
        if (wr == 1) PG8_BAR;
        PG8_WAIT_V(2); PG8_BAR;
        PG8_STAGE(PG8_SB(1, 0), cB + kstep, voffB); PG8_STAGE(PG8_SA(1, 0), cA + kstep, voffA); PG8_STAGE(PG8_SB(1, 1), cB + hstep + kstep, voffB);
        PG8_WAIT_V(6); PG8_BAR;
    } else {
        PG8_STAGE(PG8_SB(0, 0), cB, voffB); PG8_STAGE(PG8_SA(0, 0), cA, voffA); PG8_STAGE(PG8_SB(0, 1), cB + hstep, voffB); PG8_STAGE(PG8_SA(0, 1), cA + hstep, voffA);
        if (wr == 1) PG8_BAR;
        PG8_WAIT_V(4); PG8_BAR;
        PG8_STAGE(PG8_SB(1, 0), cB + kstep, voffB); PG8_STAGE(PG8_SA(1, 0), cA + kstep, voffA); PG8_STAGE(PG8_SB(1, 1), cB + hstep + kstep, voffB);
        PG8_WAIT_V(6); PG8_BAR;
    }
    for (;;) {
        const bool has_next = S.next(ui + 1, nxt);
        const char* nA = has_next ? (const char*)g.A + (size_t)nxt.pm * tstep : cA; const char* nB = has_next ? (const char*)g.Bt + (size_t)nxt.pn * tstep : cB;
        for (int t = 0; t < nt; t += 2) {
            const bool last = (t == nt - 2);
            const char* a1 = cA + (size_t)(t + 1) * kstep;
            const char* a2 = last ? nA : cA + (size_t)(t + 2) * kstep; const char* b2 = last ? nB : cB + (size_t)(t + 2) * kstep;
            const char* a3 = a2 + kstep; const char* b3 = b2 + kstep;
            if (last && has_next) S.a_ready(nxt);
            if constexpr (SP2) {
            PG8_LDB(B0, 0, 0); PG8_LDB(B1, 0, 1); PG8_SCHED; PG8_LDA(At, 0, 0); PG8_STAGE(PG8_SA(1, 1), a1 + hstep, voffA);
            PG8_WAIT_V(8); PG8_WAIT_L(0); PG8_BAR; PG8_MMA(0, 0, At, B0); PG8_MMA(0, 1, At, B1); PG8_BAR; PG8_SCHED;
            PG8_LDA(At, 0, 1); PG8_STAGE(PG8_SB(0, 0), b2, voffB); PG8_STAGE(PG8_SB(0, 1), b2 + hstep, voffB); PG8_STAGE(PG8_SA(0, 0), a2, voffA);
            PG8_WAIT_V(8); PG8_WAIT_L(0); PG8_BAR; PG8_MMA(1, 0, At, B0); PG8_MMA(1, 1, At, B1); PG8_BAR; PG8_SCHED;
            PG8_LDB(B0, 1, 0); PG8_LDB(B1, 1, 1); PG8_SCHED; PG8_LDA(At, 1, 0); PG8_STAGE(PG8_SA(0, 1), a2 + hstep, voffA);
            PG8_WAIT_V(8); PG8_WAIT_L(0); PG8_BAR; PG8_MMA(0, 0, At, B0); PG8_MMA(0, 1, At, B1); PG8_BAR; PG8_SCHED;
            PG8_LDA(At, 1, 1); PG8_STAGE(PG8_SB(1, 0), b3, voffB); PG8_STAGE(PG8_SB(1, 1), b3 + hstep, voffB); PG8_STAGE(PG8_SA(1, 0), a3, voffA);
            PG8_WAIT_V(8); PG8_WAIT_L(0); PG8_BAR; PG8_MMA(1, 0, At, B0); PG8_MMA(1, 1, At, B1); PG8_BAR; PG8_SCHED;
            } else {
            PG8_LDB(B0, 0, 0); PG8_SCHED; PG8_LDA(At, 0, 0); PG8_STAGE(PG8_SA(1, 1), a1 + hstep, voffA);
            PG8_WAIT_L(8); PG8_BAR; PG8_WAIT_L(0); PG8_MMA(0, 0, At, B0); PG8_BAR; PG8_SCHED;
            PG8_LDB(B1, 0, 1); PG8_STAGE(PG8_SB(0, 0), b2, voffB);
            PG8_BAR; PG8_WAIT_L(0); PG8_MMA(0, 1, At, B1); PG8_BAR;
            PG8_LDA(At, 0, 1); PG8_STAGE(PG8_SA(0, 0), a2, voffA);
            PG8_BAR; PG8_WAIT_L(0); PG8_MMA(1, 0, At, B0); PG8_BAR; PG8_SCHED;
            PG8_STAGE(PG8_SB(0, 1), b2 + hstep, voffB);
            PG8_WAIT_V(6); PG8_BAR; PG8_MMA(1, 1, At, B1); PG8_BAR;
            PG8_LDB(B0, 1, 0); PG8_SCHED; PG8_LDA(At, 1, 0); PG8_STAGE(PG8_SA(0, 1), a2 + hstep, voffA);
            PG8_WAIT_L(8); PG8_BAR; PG8_WAIT_L(0); PG8_MMA(0, 0, At, B0); PG8_BAR; PG8_SCHED;
            PG8_LDB(B1, 1, 1); PG8_STAGE(PG8_SB(1, 0), b3, voffB);
            PG8_BAR; PG8_WAIT_L(0); PG8_MMA(0, 1, At, B1); PG8_BAR;
            PG8_LDA(At, 1, 1); PG8_STAGE(PG8_SA(1, 0), a3, voffA);
            PG8_BAR; PG8_WAIT_L(0); PG8_MMA(1, 0, At, B0); PG8_BAR; PG8_SCHED;
            PG8_STAGE(PG8_SB(1, 1), b3 + hstep, voffB);
            PG8_WAIT_V(6); PG8_BAR; PG8_MMA(1, 1, At, B1); PG8_BAR;
            }
        }
        if constexpr (ALIGN_EPI) { if (wr == 0) PG8_BAR; }
        if constexpr (!Epi::AFTER_DRAIN) { E(acc, cur, wr, wc, fr, fq); S.done(cur); }
        if (!has_next) break;
#pragma unroll
        for (int a = 0; a < 2; ++a)
#pragma unroll
            for (int b = 0; b < 2; ++b)
#pragma unroll
                for (int m = 0; m < 4; ++m)
#pragma unroll
                    for (int n = 0; n < 2; ++n) acc[a][b][m][n] = (f32x4){0.f, 0.f, 0.f, 0.f};
        cur = nxt; cA = nA; cB = nB; ++ui;
        if constexpr (ALIGN_EPI) { if (wr == 1) PG8_BAR; }
    }
    PG8_WAIT_V(0);
    if constexpr (!ALIGN_EPI) { if (wr == 0) PG8_BAR; }
    PG8_BAR;
    if constexpr (Epi::AFTER_DRAIN) { E.fused(acc, cur, wr, wc, fr, fq, lds, wid, lane); S.done(cur); }
#undef PG8_SA
#undef PG8_SB
#undef PG8_STAGE
#undef PG8_LDA
#undef PG8_LDB
#undef PG8_MMA
#undef PG8_WAIT_V
#undef PG8_WAIT_L
#undef PG8_BAR
#undef PG8_SCHED
}

template <class Epi, class Sched, bool ALIGN_EPI, bool SP2, int INIT, bool DOEPI>
__device__ __forceinline__ void gemm_phase_acc(PG8_LAS unsigned char* lds, const Gemm g, const Sched& S, const Epi& E, f32x4 (&acc)[2][2][4][2]) {
    const int tid = threadIdx.x, wid = __builtin_amdgcn_readfirstlane(tid >> 6), lane = tid & 63, wr = wid >> 2, wc = wid & 3, fr = lane & 15, fq = lane >> 4;
    const int K = g.K, LD = g.ld, nt = K / BK;
    unsigned voffA[2], voffB[2];
#pragma unroll
    for (int i = 0; i < 2; ++i) { int R, C; stage_rc(tid * 16 + i * 8192, R, C); const int Rb = Epi::PERM ? ((R & ~31) + perm32(R & 31)) : R;
        voffA[i] = (unsigned)(R * LD + C) * 2u; voffB[i] = (unsigned)(Rb * LD + C) * 2u; }
    const size_t kstep = (size_t)(BK * 2);
    const size_t hstep = (size_t)HALF * LD * 2;
    const size_t tstep = 2 * hstep;
    const unsigned ldsw = (unsigned)wid * 1024u;
    const int aoff = lds_byte(wr * 64 + fr, fq * 8), boff = lds_byte(wc * 32 + fr, fq * 8);
#define PG8_SA(b, h) (((b) * 2 + (h)) * HTB)
#define PG8_SB(b, h) ((4 + (b) * 2 + (h)) * HTB)
#define PG8_STAGE(bufoff, gbase, voff) do { _Pragma("unroll") for (int _i = 0; _i < 2; ++_i) \
        __builtin_amdgcn_global_load_lds((const unsigned*)((const char*)(gbase) + (voff)[_i]), (PG8_LAS unsigned*)(lds + (bufoff) + ldsw + _i * 8192), 16, 0, 0); } while (0)
#define PG8_LDA(dst, b, h) do { _Pragma("unroll") for (int m = 0; m < 4; ++m) _Pragma("unroll") for (int k = 0; k < 2; ++k) dst[m][k] = *(const PG8_LAS bf16x8*)(lds + PG8_SA(b, h) + aoff + m * 2048 + k * 1024); } while (0)
#define PG8_LDB(dst, b, h) do { _Pragma("unroll") for (int n = 0; n < 2; ++n) _Pragma("unroll") for (int k = 0; k < 2; ++k) dst[n][k] = *(const PG8_LAS bf16x8*)(lds + PG8_SB(b, h) + boff + n * 2048 + k * 1024); } while (0)
#define PG8_MMA(ai, bj, At, Bt) do { __builtin_amdgcn_s_setprio(1); _Pragma("unroll") for (int m = 0; m < 4; ++m) _Pragma("unroll") for (int n = 0; n < 2; ++n) _Pragma("unroll") for (int k = 0; k < 2; ++k) \
        acc[ai][bj][m][n] = __builtin_amdgcn_mfma_f32_16x16x32_bf16(Bt[n][k], At[m][k], acc[ai][bj][m][n], 0, 0, 0); __builtin_amdgcn_s_setprio(0); } while (0)
#define PG8_WAIT_V(n) asm volatile("s_waitcnt vmcnt(" #n ")" ::: "memory")
#define PG8_WAIT_L(n) asm volatile("s_waitcnt lgkmcnt(" #n ")" ::: "memory")
#define PG8_BAR __builtin_amdgcn_s_barrier()
#define PG8_SCHED __builtin_amdgcn_sched_barrier(0)
    Unit cur, nxt; int ui = 0;
    if (!S.next(0, cur)) return;
    if constexpr (INIT == 1) {
#pragma unroll
    for (int a = 0; a < 2; ++a)
#pragma unroll
        for (int b = 0; b < 2; ++b)
#pragma unroll
            for (int m = 0; m < 4; ++m)
#pragma unroll
                for (int n = 0; n < 2; ++n) acc[a][b][m][n] = (f32x4){0.f, 0.f, 0.f, 0.f};
    }
    bf16x8 At[4][2], B0[2][2], B1[2][2];
    const char* cA = (const char*)g.A + (size_t)cur.pm * tstep; const char* cB = (const char*)g.Bt + (size_t)cur.pn * tstep;
    S.a_ready(cur);
    if constexpr (SP2) {
        PG8_STAGE(PG8_SB(0, 0), cB, voffB); PG8_STAGE(PG8_SB(0, 1), cB + hstep, voffB); PG8_STAGE(PG8_SA(0, 0), cA, voffA); PG8_STAGE(PG8_SA(0, 1), cA + hstep, voffA);
        if (wr == 1) PG8_BAR;
        PG8_WAIT_V(2); PG8_BAR;
        PG8_STAGE(PG8_SB(1, 0), cB + kstep, voffB); PG8_STAGE(PG8_SA(1, 0), cA + kstep, voffA); PG8_STAGE(PG8_SB(1, 1), cB + hstep + kstep, voffB);
        PG8_WAIT_V(6); PG8_BAR;
    } else {
        PG8_STAGE(PG8_SB(0, 0), cB, voffB); PG8_STAGE(PG8_SA(0, 0), cA, voffA); PG8_STAGE(PG8_SB(0, 1), cB + hstep, voffB); PG8_STAGE(PG8_SA(0, 1), cA + hstep, voffA);
        if (wr == 1) PG8_BAR;
        PG8_WAIT_V(4); PG8_BAR;
        PG8_STAGE(PG8_SB(1, 0), cB + kstep, voffB); PG8_STAGE(PG8_SA(1, 0), cA + kstep, voffA); PG8_STAGE(PG8_SB(1, 1), cB + hstep + kstep, voffB);
        PG8_WAIT_V(6); PG8_BAR;
    }
    for (;;) {
        const bool has_next = S.next(ui + 1, nxt);
        const char* nA = has_next ? (const char*)g.A + (size_t)nxt.pm * tstep : cA; const char* nB = has_next ? (const char*)g.Bt + (size_t)nxt.pn * tstep : cB;
        for (int t = 0; t < nt; t += 2) {
            const bool last = (t == nt - 2);
            const char* a1 = cA + (size_t)(t + 1) * kstep;
            const char* a2 = last ? nA : cA + (size_t)(t + 2) * kstep; const char* b2 = last ? nB : cB + (size_t)(t + 2) * kstep;
            const char* a3 = a2 + kstep; const char* b3 = b2 + kstep;
            if (last && has_next) S.a_ready(nxt);
            if constexpr (SP2) {
            PG8_LDB(B0, 0, 0); PG8_LDB(B1, 0, 1); PG8_SCHED; PG8_LDA(At, 0, 0); PG8_STAGE(PG8_SA(1, 1), a1 + hstep, voffA);
            PG8_WAIT_V(8); PG8_WAIT_L(0); PG8_BAR; PG8_MMA(0, 0, At, B0); PG8_MMA(0, 1, At, B1); PG8_BAR; PG8_SCHED;
            PG8_LDA(At, 0, 1); PG8_STAGE(PG8_SB(0, 0), b2, voffB); PG8_STAGE(PG8_SB(0, 1), b2 + hstep, voffB); PG8_STAGE(PG8_SA(0, 0), a2, voffA);
            PG8_WAIT_V(8); PG8_WAIT_L(0); PG8_BAR; PG8_MMA(1, 0, At, B0); PG8_MMA(1, 1, At, B1); PG8_BAR; PG8_SCHED;
            PG8_LDB(B0, 1, 0); PG8_LDB(B1, 1, 1); PG8_SCHED; PG8_LDA(At, 1, 0); PG8_STAGE(PG8_SA(0, 1), a2 + hstep, voffA);
            PG8_WAIT_V(8); PG8_WAIT_L(0); PG8_BAR; PG8_MMA(0, 0, At, B0); PG8_MMA(0, 1, At, B1); PG8_BAR; PG8_SCHED;
            PG8_LDA(At, 1, 1); PG8_STAGE(PG8_SB(1, 0), b3, voffB); PG8_STAGE(PG8_SB(1, 1), b3 + hstep, voffB); PG8_STAGE(PG8_SA(1, 0), a3, voffA);
            PG8_WAIT_V(8); PG8_WAIT_L(0); PG8_BAR; PG8_MMA(1, 0, At, B0); PG8_MMA(1, 1, At, B1); PG8_BAR; PG8_SCHED;
            } else {
            PG8_LDB(B0, 0, 0); PG8_SCHED; PG8_LDA(At, 0, 0); PG8_STAGE(PG8_SA(1, 1), a1 + hstep, voffA);
            PG8_WAIT_L(8); PG8_BAR; PG8_WAIT_L(0); PG8_MMA(0, 0, At, B0); PG8_BAR; PG8_SCHED;
            PG8_LDB(B1, 0, 1); PG8_STAGE(PG8_SB(0, 0), b2, voffB);
            PG8_BAR; PG8_WAIT_L(0); PG8_MMA(0, 1, At, B1); PG8_BAR;
            PG8_LDA(At, 0, 1); PG8_STAGE(PG8_SA(0, 0), a2, voffA);
            PG8_BAR; PG8_WAIT_L(0); PG8_MMA(1, 0, At, B0); PG8_BAR; PG8_SCHED;
            PG8_STAGE(PG8_SB(0, 1), b2 + hstep, voffB);
            PG8_WAIT_V(6); PG8_BAR; PG8_MMA(1, 1, At, B1); PG8_BAR;
            PG8_LDB(B0, 1, 0); PG8_SCHED; PG8_LDA(At, 1, 0); PG8_STAGE(PG8_SA(0, 1), a2 + hstep, voffA);
            PG8_WAIT_L(8); PG8_BAR; PG8_WAIT_L(0); PG8_MMA(0, 0, At, B0); PG8_BAR; PG8_SCHED;
            PG8_LDB(B1, 1, 1); PG8_STAGE(PG8_SB(1, 0), b3, voffB);
            PG8_BAR; PG8_WAIT_L(0); PG8_MMA(0, 1, At, B1); PG8_BAR;
            PG8_LDA(At, 1, 1); PG8_STAGE(PG8_SA(1, 0), a3, voffA);
            PG8_BAR; PG8_WAIT_L(0); PG8_MMA(1, 0, At, B0); PG8_BAR; PG8_SCHED;
            PG8_STAGE(PG8_SB(1, 1), b3 + hstep, voffB);
            PG8_WAIT_V(6); PG8_BAR; PG8_MMA(1, 1, At, B1); PG8_BAR;
            }
        }
        if constexpr (ALIGN_EPI) { if (wr == 0) PG8_BAR; }
        if constexpr (!Epi::AFTER_DRAIN && DOEPI) { E(acc, cur, wr, wc, fr, fq); S.done(cur); }
        if (!has_next) break;
#pragma unroll
        for (int a = 0; a < 2; ++a)
#pragma unroll
            for (int b = 0; b < 2; ++b)
#pragma unroll
                for (int m = 0; m < 4; ++m)
#pragma unroll
                    for (int n = 0; n < 2; ++n) acc[a][b][m][n] = (f32x4){0.f, 0.f, 0.f, 0.f};
        cur = nxt; cA = nA; cB = nB; ++ui;
        if constexpr (ALIGN_EPI) { if (wr == 1) PG8_BAR; }
    }
    PG8_WAIT_V(0);
    if constexpr (!ALIGN_EPI) { if (wr == 0) PG8_BAR; }
    PG8_BAR;
    if constexpr (Epi::AFTER_DRAIN && DOEPI) { E.fused(acc, cur, wr, wc, fr, fq, lds, wid, lane); S.done(cur); }
#undef PG8_SA
#undef PG8_SB
#undef PG8_STAGE
#undef PG8_LDA
#undef PG8_LDB
#undef PG8_MMA
#undef PG8_WAIT_V
#undef PG8_WAIT_L
#undef PG8_BAR
#undef PG8_SCHED
}


template <class Epi, class Sched, bool ALIGN_EPI>
__device__ __forceinline__ void gemm_phase_x(PG8_LAS unsigned char* lds, const Sched& S, const Epi& E) {
    static_assert(Epi::PERM && !Epi::AFTER_DRAIN, "gemm_phase_x: PERM in-loop epilogues only");
    const int tid = threadIdx.x, wid = __builtin_amdgcn_readfirstlane(tid >> 6), lane = tid & 63, wr = wid >> 2, wc = wid & 3, fr = lane & 15, fq = lane >> 4;
    unsigned vA0[2], vB0[2], vA1[2], vB1[2];
#pragma unroll
    for (int i = 0; i < 2; ++i) { int R, C; stage_rc(tid * 16 + i * 8192, R, C); const int Rb = (R & ~31) + perm32(R & 31);
        vA0[i] = (unsigned)(R * 1024 + C) * 2u; vB0[i] = (unsigned)(Rb * 1024 + C) * 2u; vA1[i] = (unsigned)(R * 256 + C) * 2u; vB1[i] = (unsigned)(Rb * 256 + C) * 2u; }
    const size_t kstep = (size_t)(BK * 2);
    const unsigned ldsw = (unsigned)wid * 1024u;
    const int aoff = lds_byte(wr * 64 + fr, fq * 8), boff = lds_byte(wc * 32 + fr, fq * 8);
#define PG8_SA(b, h) (((b) * 2 + (h)) * HTB)
#define PG8_SB(b, h) ((4 + (b) * 2 + (h)) * HTB)
#define PG8_STAGE(bufoff, gbase, voff) do { _Pragma("unroll") for (int _i = 0; _i < 2; ++_i) \
        __builtin_amdgcn_global_load_lds((const unsigned*)((const char*)(gbase) + (voff)[_i]), (PG8_LAS unsigned*)(lds + (bufoff) + ldsw + _i * 8192), 16, 0, 0); } while (0)
#define PG8_LDA(dst, b, h) do { _Pragma("unroll") for (int m = 0; m < 4; ++m) _Pragma("unroll") for (int k = 0; k < 2; ++k) dst[m][k] = *(const PG8_LAS bf16x8*)(lds + PG8_SA(b, h) + aoff + m * 2048 + k * 1024); } while (0)
#define PG8_LDB(dst, b, h) do { _Pragma("unroll") for (int n = 0; n < 2; ++n) _Pragma("unroll") for (int k = 0; k < 2; ++k) dst[n][k] = *(const PG8_LAS bf16x8*)(lds + PG8_SB(b, h) + boff + n * 2048 + k * 1024); } while (0)
#define PG8_MMA(ai, bj, At, Bt) do { __builtin_amdgcn_s_setprio(1); _Pragma("unroll") for (int m = 0; m < 4; ++m) _Pragma("unroll") for (int n = 0; n < 2; ++n) _Pragma("unroll") for (int k = 0; k < 2; ++k) \
        acc[ai][bj][m][n] = __builtin_amdgcn_mfma_f32_16x16x32_bf16(Bt[n][k], At[m][k], acc[ai][bj][m][n], 0, 0, 0); __builtin_amdgcn_s_setprio(0); } while (0)
#define PG8_WAIT_V(n) asm volatile("s_waitcnt vmcnt(" #n ")" ::: "memory")
#define PG8_WAIT_L(n) asm volatile("s_waitcnt lgkmcnt(" #n ")" ::: "memory")
#define PG8_BAR __builtin_amdgcn_s_barrier()
#define PG8_SCHED __builtin_amdgcn_sched_barrier(0)
#define PG8_SELV(dst, sel, a0, a1) do { dst[0] = (sel) ? a1[0] : a0[0]; dst[1] = (sel) ? a1[1] : a0[1]; } while (0)
    UnitX cur, nxt; int ui = 0;
    if (!S.next(0, cur)) return;
    f32x4 acc[2][2][4][2];
#pragma unroll
    for (int a = 0; a < 2; ++a)
#pragma unroll
        for (int b2_ = 0; b2_ < 2; ++b2_)
#pragma unroll
            for (int m = 0; m < 4; ++m)
#pragma unroll
                for (int n = 0; n < 2; ++n) acc[a][b2_][m][n] = (f32x4){0.f, 0.f, 0.f, 0.f};
    bf16x8 At[4][2], B0[2][2], B1[2][2];
    const char* cA = cur.A; const char* cB = cur.B;
    unsigned cvA[2], cvB[2]; PG8_SELV(cvA, cur.ldsel, vA0, vA1); PG8_SELV(cvB, cur.ldsel, vB0, vB1);
    size_t hC = cur.ldsel ? (size_t)HALF * 256 * 2 : (size_t)HALF * 1024 * 2;
    PG8_STAGE(PG8_SB(0, 0), cB, cvB); PG8_STAGE(PG8_SB(0, 1), cB + hC, cvB); PG8_STAGE(PG8_SA(0, 0), cA, cvA); PG8_STAGE(PG8_SA(0, 1), cA + hC, cvA);
    if (wr == 1) PG8_BAR;
    PG8_WAIT_V(2); PG8_BAR;
    PG8_STAGE(PG8_SB(1, 0), cB + kstep, cvB); PG8_STAGE(PG8_SA(1, 0), cA + kstep, cvA); PG8_STAGE(PG8_SB(1, 1), cB + hC + kstep, cvB);
    PG8_WAIT_V(6); PG8_BAR;
    for (;;) {
        const bool has_next = S.next(ui + 1, nxt);
        const char* nA = has_next ? nxt.A : cA; const char* nB = has_next ? nxt.B : cB;
        const int nsel = has_next ? nxt.ldsel : cur.ldsel;
        unsigned nvA[2], nvB[2]; PG8_SELV(nvA, nsel, vA0, vA1); PG8_SELV(nvB, nsel, vB0, vB1);
        const size_t hN = nsel ? (size_t)HALF * 256 * 2 : (size_t)HALF * 1024 * 2;
        const int nt = cur.nt;
        for (int t = 0; t < nt; t += 2) {
            const bool last = (t == nt - 2);
            const char* a1 = cA + (size_t)(t + 1) * kstep;
            const char* a2 = last ? nA : cA + (size_t)(t + 2) * kstep; const char* b2 = last ? nB : cB + (size_t)(t + 2) * kstep;
            const char* a3 = a2 + kstep; const char* b3 = b2 + kstep;
            const size_t h2 = last ? hN : hC;
            unsigned v2A[2], v2B[2]; v2A[0] = last ? nvA[0] : cvA[0]; v2A[1] = last ? nvA[1] : cvA[1]; v2B[0] = last ? nvB[0] : cvB[0]; v2B[1] = last ? nvB[1] : cvB[1];
            PG8_LDB(B0, 0, 0); PG8_LDB(B1, 0, 1); PG8_SCHED; PG8_LDA(At, 0, 0); PG8_STAGE(PG8_SA(1, 1), a1 + hC, cvA);
            PG8_WAIT_V(8); PG8_WAIT_L(0); PG8_BAR; PG8_MMA(0, 0, At, B0); PG8_MMA(0, 1, At, B1); PG8_BAR; PG8_SCHED;
            PG8_LDA(At, 0, 1); PG8_STAGE(PG8_SB(0, 0), b2, v2B); PG8_STAGE(PG8_SB(0, 1), b2 + h2, v2B); PG8_STAGE(PG8_SA(0, 0), a2, v2A);
            PG8_WAIT_V(8); PG8_WAIT_L(0); PG8_BAR; PG8_MMA(1, 0, At, B0); PG8_MMA(1, 1, At, B1); PG8_BAR; PG8_SCHED;
            PG8_LDB(B0, 1, 0); PG8_LDB(B1, 1, 1); PG8_SCHED; PG8_LDA(At, 1, 0); PG8_STAGE(PG8_SA(0, 1), a2 + h2, v2A);
            PG8_WAIT_V(8); PG8_WAIT_L(0); PG8_BAR; PG8_MMA(0, 0, At, B0); PG8_MMA(0, 1, At, B1); PG8_BAR; PG8_SCHED;
            PG8_LDA(At, 1, 1); PG8_STAGE(PG8_SB(1, 0), b3, v2B); PG8_STAGE(PG8_SB(1, 1), b3 + h2, v2B); PG8_STAGE(PG8_SA(1, 0), a3, v2A);
            PG8_WAIT_V(8); PG8_WAIT_L(0); PG8_BAR; PG8_MMA(1, 0, At, B0); PG8_MMA(1, 1, At, B1); PG8_BAR; PG8_SCHED;
        }
        if constexpr (ALIGN_EPI) { if (wr == 0) PG8_BAR; }
        E(acc, cur, wr, wc, fr, fq);
        if (!has_next) break;
#pragma unroll
        for (int a = 0; a < 2; ++a)
#pragma unroll
            for (int b2_ = 0; b2_ < 2; ++b2_)
#pragma unroll
                for (int m = 0; m < 4; ++m)
#pragma unroll
                    for (int n = 0; n < 2; ++n) acc[a][b2_][m][n] = (f32x4){0.f, 0.f, 0.f, 0.f};
        cur = nxt; cA = nA; cB = nB; cvA[0] = nvA[0]; cvA[1] = nvA[1]; cvB[0] = nvB[0]; cvB[1] = nvB[1]; hC = hN; ++ui;
        if constexpr (ALIGN_EPI) { if (wr == 1) PG8_BAR; }
    }
    PG8_WAIT_V(0);
    if constexpr (!ALIGN_EPI) { if (wr == 0) PG8_BAR; }
    PG8_BAR;
#undef PG8_SA
#undef PG8_SB
#undef PG8_STAGE
#undef PG8_LDA
#undef PG8_LDB
#undef PG8_MMA
#undef PG8_WAIT_V
#undef PG8_WAIT_L
#undef PG8_BAR
#undef PG8_SCHED
#undef PG8_SELV
}
}

#ifndef PG8_SP2
#define PG8_SP2 true
#endif
#ifndef PG8_ALIGN
#define PG8_ALIGN true
#endif
constexpr int NWAVES = 8;
constexpr int BATCH = 2, SEQ = 8192, DM = 1024, M = BATCH * SEQ, DIN = 3328, DPLE = 256, NL = 2, NH = 8, HD = 64, NBLK = 32;
constexpr int DIN_MAIN = 3072;
constexpr int ZQ = 0, ZK = 512, ZV = 1024, ZGA = 1536, ZXB = 2048, ZGB = 2304, ZUC = 2560, ZVC = 2816, ZGC = 3072;
constexpr float C2 = 0.125f * 1.4426950408889634f;
constexpr float LOG2E = 1.4426950408889634f;
constexpr int NBIAS = 129;
constexpr size_t MiB = 1u << 20, KiB = 1u << 10;
constexpr size_t WS_CTL = 0, CTL_ZERO_BYTES = 1 * MiB;
constexpr size_t CTL_KSUM = 512 * KiB;
constexpr size_t CTL_NTOT = 768 * KiB;
constexpr size_t CTL_NNEAR = 776 * KiB;
constexpr size_t WS_WIN = 1 * MiB, WIN_BYTES = (size_t)DIN * DM * 2;
constexpr size_t WS_WOUT = 14 * MiB, WS_WGATE = 18 * MiB, WS_WPLE = 22 * MiB;
constexpr size_t WS_SGUW = 23 * MiB;
constexpr size_t WS_POOLWT = 23 * MiB + 256 * KiB;
constexpr size_t WS_BIAS2 = 23 * MiB + 512 * KiB;
constexpr size_t WS_SSQ = 23 * MiB + 768 * KiB;
constexpr size_t WS_STATS = 24 * MiB;
constexpr size_t WS_PB = 26 * MiB;
constexpr size_t WS_XN = 42 * MiB;
constexpr size_t WS_Z = 74 * MiB;
constexpr size_t WS_OPART = 178 * MiB;
constexpr size_t WS_LSE = 242 * MiB;
constexpr size_t WS_H1B = 178 * MiB, WS_TB = 210 * MiB;
constexpr size_t WS_GCPART = 178 * MiB;
constexpr size_t WS_LISTS = 244 * MiB;
constexpr size_t WS_CNT = 252 * MiB;
constexpr size_t WS_END = 253 * MiB;
constexpr int CW_TMO = 0, CW_CODE = 1, CW_BAR = 4096;
constexpr int RING_OFF = 0, RING_BYTES = 131072;
constexpr int LDSCTL_OFF = RING_BYTES, MISC_OFF = LDSCTL_OFF + 320;
constexpr int LDS_BYTES = 147456;


#ifndef REP_ATTN
#define REP_ATTN 1
#endif
#ifndef REP_COMB
#define REP_COMB 1
#endif
#ifndef REP_MIX
#define REP_MIX 1
#endif
#ifndef REP_SGU
#define REP_SGU 1
#endif
#ifndef REP_POOL
#define REP_POOL 1
#endif
#ifndef REP_GATE
#define REP_GATE 1
#endif
#ifndef REP_GEMM1
#define REP_GEMM1 1
#endif
#ifndef REP_PRO
#define REP_PRO 1
#endif
#ifndef REP_BAR
#define REP_BAR 1
#endif
#ifndef REP_OUT0
#define REP_OUT0 1
#endif
#ifndef REPB
#define REPB 0
#endif
#ifndef REP_T
#define REP_T 1
#endif
#ifndef REP_SIG
#define REP_SIG 1
#endif

#define GAS __attribute__((address_space(1)))
#define LAS __attribute__((address_space(3)))
typedef unsigned short bf16;
typedef unsigned v4u __attribute__((ext_vector_type(4)));
typedef float f32x4 __attribute__((ext_vector_type(4)));
typedef short bf16x8 __attribute__((ext_vector_type(8)));
typedef GAS unsigned gu32;
typedef GAS unsigned long long gu64;
#define RLX_AGENT __ATOMIC_RELAXED, __HIP_MEMORY_SCOPE_AGENT
#define LDS_WAIT() asm volatile("s_waitcnt lgkmcnt(0)" ::: "memory")
#define VM_WAIT() asm volatile("s_waitcnt vmcnt(0)" ::: "memory")
__device__ __forceinline__ unsigned long long rt() { return __builtin_amdgcn_s_memrealtime(); }
__device__ __forceinline__ unsigned f2bf(float f) { unsigned u = __builtin_bit_cast(unsigned, f); return (u + 0x7fffu + ((u >> 16) & 1u)) >> 16; }
__device__ __forceinline__ unsigned pk2(float lo, float hi) { return f2bf(lo) | (f2bf(hi) << 16); }

#define XB_TMO      128
#define XB_XCNT(j)  (256  + 64 * (j))
#define XB_XSUB(j)  (1280 + 64 * (j))
#define XB_XGEN(j)  (2304 + 64 * (j))
#define XB_TOP      3328
#define XB_TOPGEN   3392
#define XCD_BAR_WORDS 3456
#define XB_SPIN_CAP (1u << 18)

__device__ __forceinline__ unsigned xb_ld(unsigned* p)              { return __hip_atomic_load(p, __ATOMIC_RELAXED, __HIP_MEMORY_SCOPE_AGENT); }
__device__ __forceinline__ unsigned xb_add(unsigned* p, unsigned v) { return __hip_atomic_fetch_add(p, v, __ATOMIC_RELAXED, __HIP_MEMORY_SCOPE_AGENT); }
__device__ __forceinline__ unsigned xb_xcc_id() { return (unsigned)__builtin_amdgcn_s_getreg((3 << 11) | 20) & 0xFu; }
#define XB_SPIN(cond, bar) do { unsigned _sp = 0; while (cond) { __builtin_amdgcn_s_sleep(1); \
    if ((++_sp & 255u) == 0u) { if (xb_ld(&(bar)[XB_TMO])) break; if (_sp > XB_SPIN_CAP) { atomicAdd(&(bar)[XB_TMO], 1u); break; } } } } while (0)

struct XcdBarrier {
    unsigned* bar; unsigned x;
    volatile LAS unsigned* st;
};

__device__ __forceinline__ XcdBarrier xcd_barrier_post(unsigned* bar, volatile LAS unsigned* st) {
    XcdBarrier b; b.bar = bar; b.x = xb_xcc_id(); b.st = st;
    if (threadIdx.x == 0) (void)xb_add(&bar[XB_XCNT(b.x)], 1u);
    return b;
}
__device__ __forceinline__ void xcd_barrier_complete(unsigned* bar, unsigned x, unsigned& nloc, unsigned& nx) {
    const unsigned G = gridDim.x * gridDim.y * gridDim.z;
    unsigned sum, cnt, mine, sp = 0u;
    for (;;) {
        sum = 0u; cnt = 0u; mine = 0u;
#pragma unroll
        for (unsigned j = 0; j < 16; ++j) { const unsigned c = xb_ld(&bar[XB_XCNT(j)]); sum += c; cnt += (c > 0u) ? 1u : 0u; mine = (j == x) ? c : mine; }
        if (sum == G) break;
        __builtin_amdgcn_s_sleep(1);
        if ((++sp & 255u) == 0u) { if (xb_ld(&bar[XB_TMO])) break; if (sp > XB_SPIN_CAP) { atomicAdd(&bar[XB_TMO], 1u); break; } }
    }
    nloc = mine > 0u ? mine : 1u; nx = cnt > 0u ? cnt : 1u;
}

__device__ __forceinline__ void xcd_barrier(const XcdBarrier& b) {
    asm volatile("s_waitcnt vmcnt(0)" ::: "memory");
    __syncthreads();
    if (threadIdx.x == 0) {
        unsigned* bar = b.bar;
        __builtin_amdgcn_s_waitcnt(0);
        unsigned nloc = b.st[0], nx = b.st[1];
        if (nloc == 0u) { xcd_barrier_complete(bar, b.x, nloc, nx); b.st[0] = nloc; b.st[1] = nx; }
        const unsigned old = xb_add(&bar[XB_XSUB(b.x)], 1u);
        const unsigned gen = old / nloc;
        if (old + 1u == (gen + 1u) * nloc) {
            __builtin_amdgcn_fence(__ATOMIC_RELEASE, "agent");
            asm volatile("s_waitcnt vmcnt(0)" ::: "memory");
            const unsigned og = xb_add(&bar[XB_TOP], 1u);
            const unsigned tg = og / nx;
            if (og + 1u == (tg + 1u) * nx) xb_add(&bar[XB_TOPGEN], 1u);
            else XB_SPIN(xb_ld(&bar[XB_TOPGEN]) == tg, bar);
            __builtin_amdgcn_fence(__ATOMIC_ACQUIRE, "agent");
            xb_add(&bar[XB_XGEN(b.x)], 1u);
            asm volatile("s_waitcnt vmcnt(0)" ::: "memory");
        } else {
            XB_SPIN(xb_ld(&bar[XB_XGEN(b.x)]) == gen, bar);
            __builtin_amdgcn_fence(__ATOMIC_ACQUIRE, "agent");
            asm volatile("s_waitcnt vmcnt(0)" ::: "memory");
        }
    }
    __syncthreads();
}
namespace pg8 {
struct EpiPleFinal {
    static constexpr bool PERM = true, AFTER_DRAIN = true;
    const bf16_t* T; const bf16_t* h1; float* out; const float* fg; float* ssq; XcdBarrier bar;
    __device__ __forceinline__ void fused(f32x4 (&acc)[2][2][4][2], const Unit& u, int wr, int wc, int fr, int fq, PG8_LAS unsigned char* lds, int wid, int lane) const {
        PG8_LAS float* P = (PG8_LAS float*)lds;
        PG8_LAS float* S = (PG8_LAS float*)(lds + 4096);
        const int col0 = u.pn * BM + wc * 32 + 8 * fq;
#pragma unroll
        for (int ai = 0; ai < 2; ++ai)
#pragma unroll
            for (int mp = 0; mp < 2; ++mp) {
                u32x4 twv[2][2], hwv[2][2];
#pragma unroll
                for (int mi = 0; mi < 2; ++mi) { const int rl = ai * HALF + wr * 64 + (2 * mp + mi) * 16 + fr; const size_t off = (size_t)(u.pm * BM + rl) * 1024 + col0;
#pragma unroll
                    for (int bj = 0; bj < 2; ++bj) { twv[mi][bj] = *(const u32x4*)(T + off + bj * HALF); hwv[mi][bj] = *(const u32x4*)(h1 + off + bj * HALF); } }
                asm volatile("" ::: "memory");
#pragma unroll
                for (int mi = 0; mi < 2; ++mi) { const int m = 2 * mp + mi;
                const int rl = ai * HALF + wr * 64 + m * 16 + fr;
                float q = 0.f;
#pragma unroll
                for (int bj = 0; bj < 2; ++bj) {
                    const u32x4 tw = twv[mi][bj], hw = hwv[mi][bj];
                    const f32x4 t0 = (f32x4){bf_lo(tw.x), bf_hi(tw.x), bf_lo(tw.y), bf_hi(tw.y)}, t1 = (f32x4){bf_lo(tw.z), bf_hi(tw.z), bf_lo(tw.w), bf_hi(tw.w)};
                    const f32x4 h0 = (f32x4){bf_lo(hw.x), bf_hi(hw.x), bf_lo(hw.y), bf_hi(hw.y)}, h1v = (f32x4){bf_lo(hw.z), bf_hi(hw.z), bf_lo(hw.w), bf_hi(hw.w)};
                    f32x4 s0 = acc[ai][bj][m][0], s1 = acc[ai][bj][m][1];
#pragma unroll
                    for (int i = 0; i < 4; ++i) { s0[i] = __builtin_amdgcn_rcpf(1.f + __expf(-s0[i])); s1[i] = __builtin_amdgcn_rcpf(1.f + __expf(-s1[i])); }
                    const f32x4 o0 = h0 + t0 * s0, o1 = h1v + t1 * s1;
                    q += (o0[0] * o0[0] + o0[1] * o0[1]) + (o0[2] * o0[2] + o0[3] * o0[3]) + (o1[0] * o1[0] + o1[1] * o1[1]) + (o1[2] * o1[2] + o1[3] * o1[3]);
                    acc[ai][bj][m][0] = o0; acc[ai][bj][m][1] = o1;
                }
                q += __shfl_xor(q, 16); q += __shfl_xor(q, 32);
                if (fq == 0) P[rl * 4 + wc] = q;
                asm volatile("" : "+v"(acc[ai][0][m][0]), "+v"(acc[ai][0][m][1]), "+v"(acc[ai][1][m][0]), "+v"(acc[ai][1][m][1]));
                }
                asm volatile("" ::: "memory");
            }
        asm volatile("s_waitcnt lgkmcnt(0)" ::: "memory"); __builtin_amdgcn_s_barrier(); asm volatile("" ::: "memory");
        const int t = wid * 64 + lane;
        if (t < 256) { const float s = (P[t * 4 + 0] + P[t * 4 + 1]) + (P[t * 4 + 2] + P[t * 4 + 3]); ssq[(size_t)(u.pm * BM + t) * 4 + u.pn] = s; }
        xcd_barrier(bar);
        if (t < 256) { const f32x4 s4 = *(const f32x4*)(ssq + (size_t)(u.pm * BM + t) * 4); S[t] = 1.0f / sqrtf(((s4[0] + s4[1]) + (s4[2] + s4[3])) * (1.0f / 1024.0f) + 1e-6f); }
        asm volatile("s_waitcnt lgkmcnt(0)" ::: "memory"); __builtin_amdgcn_s_barrier(); asm volatile("" ::: "memory");
        f32x4 gv[2][2];
#pragma unroll
        for (int bj = 0; bj < 2; ++bj) { gv[bj][0] = *(const f32x4*)(fg + col0 + bj * HALF); gv[bj][1] = *(const f32x4*)(fg + col0 + bj * HALF + 4); }
#pragma unroll
        for (int ai = 0; ai < 2; ++ai)
#pragma unroll
            for (int m = 0; m < 4; ++m) {
                const int rl = ai * HALF + wr * 64 + m * 16 + fr; const float rs = S[rl];
                const size_t off = (size_t)(u.pm * BM + rl) * 1024 + col0;
#pragma unroll
                for (int bj = 0; bj < 2; ++bj) { *(f32x4*)(out + off + bj * HALF) = acc[ai][bj][m][0] * rs * gv[bj][0]; *(f32x4*)(out + off + bj * HALF + 4) = acc[ai][bj][m][1] * rs * gv[bj][1]; }
            }
    }
};
}
struct Frame {
    LAS unsigned char* lds;
    volatile LAS unsigned* MISC;
    gu32* ctl;
    int tid, lane, wave, vcu, G;
};
__device__ __forceinline__ float wave_sum(float v) {
#pragma unroll
    for (int o = 1; o < 64; o <<= 1) v += __shfl_xor(v, o);
    return v;
}
__device__ __forceinline__ float bf2f(bf16 v) { return __uint_as_float((unsigned)v << 16); }
__device__ __forceinline__ float silu_f(float x) { return x / (1.f + __expf(-x)); }
__device__ __forceinline__ int t5_bucket(int n) {
    if (n < 16) return n;
    const float v = logf((float)n / 16.f) / 2.0794415416798357f * 16.f;
    const int l = 16 + (int)v;
    return l < 31 ? l : 31;
}
__device__ __forceinline__ void p0_transpose_item(const float* W, int K, int N, bf16* WT, LAS float* scr, int item, int lane, const float* gk = nullptr) {
    const int nblk = N / 32, kb = item / nblk, nb = item % nblk, k0 = 64 * kb, n0 = 32 * nb;
    float wv[32];
#pragma unroll
    for (int i = 0; i < 32; ++i) { const int kk = 2 * i + (lane >> 5); wv[i] = __builtin_nontemporal_load(W + (size_t)(k0 + kk) * N + n0 + (lane & 31)); }
    if (gk) {
#pragma unroll
        for (int i = 0; i < 32; ++i) wv[i] *= gk[k0 + 2 * i + (lane >> 5)]; }
#pragma unroll
    for (int i = 0; i < 32; ++i) { const int kk = 2 * i + (lane >> 5); scr[kk * 33 + (lane & 31)] = wv[i]; }
    LDS_WAIT(); asm volatile("" ::: "memory");
    const int c = lane & 7;
#pragma unroll
    for (int j = 0; j < 4; ++j) { const int n = (lane >> 3) + 8 * j; const LAS float* s = scr + (8 * c) * 33 + n;
        v4u o; o.x = pk2(s[0 * 33], s[1 * 33]); o.y = pk2(s[2 * 33], s[3 * 33]); o.z = pk2(s[4 * 33], s[5 * 33]); o.w = pk2(s[6 * 33], s[7 * 33]);
        *(GAS v4u*)(WT + (size_t)(n0 + n) * K + k0 + 8 * c) = o; }
    LDS_WAIT(); asm volatile("" ::: "memory");
}
struct Args { const float* in[13]; float* out; unsigned char* ws; int ph_lo, ph_hi, li, pad; };

template <int PART> __device__ __forceinline__ void p0_prologue(Frame& F, const Args& A) {
    unsigned char* ws = A.ws;
    LAS float* scr = (LAS float*)(F.lds + RING_OFF + F.wave * 16384);
    const int gw = F.vcu * NWAVES + F.wave, NGW = F.G * NWAVES;
    constexpr int I_IN = (DM / 64) * (DIN / 32), I_OUT = (DM / 64) * (DM / 32), I_GATE = I_OUT, I_PLE = (DPLE / 64) * (DM / 32), PL = I_IN + I_OUT + I_GATE + I_PLE;
    if (PART == 0) {
        for (int it = gw; it < I_IN + I_PLE; it += NGW) {
            if (it < I_IN) p0_transpose_item(A.in[3], DM, DIN, (bf16*)(ws + WS_WIN), scr, it, F.lane, A.in[2]);
            else p0_transpose_item(A.in[10], DPLE, DM, (bf16*)(ws + WS_WPLE), scr, it - I_IN, F.lane);
        }
    } else {
        for (int it = gw; it < I_OUT + I_GATE + PL; it += NGW) {
            int r = it;
            if (r < I_OUT) { p0_transpose_item(A.in[4], DM, DM, (bf16*)(ws + WS_WOUT), scr, r, F.lane); continue; } r -= I_OUT;
            if (r < I_GATE) { p0_transpose_item(A.in[11], DM, DM, (bf16*)(ws + WS_WGATE), scr, r, F.lane); continue; } r -= I_GATE;
            constexpr int L = 1;
            if (r < I_IN) { p0_transpose_item(A.in[3] + (size_t)L * DM * DIN, DM, DIN, (bf16*)(ws + WS_WIN + L * WIN_BYTES), scr, r, F.lane, A.in[2] + (size_t)L * DM); continue; } r -= I_IN;
            if (r < I_OUT) { p0_transpose_item(A.in[4] + (size_t)L * DM * DM, DM, DM, (bf16*)(ws + WS_WOUT + L * 2 * MiB), scr, r, F.lane); continue; } r -= I_OUT;
            if (r < I_GATE) { p0_transpose_item(A.in[11] + (size_t)L * DM * DM, DM, DM, (bf16*)(ws + WS_WGATE + L * 2 * MiB), scr, r, F.lane); continue; } r -= I_GATE;
            p0_transpose_item(A.in[10] + (size_t)L * DPLE * DM, DPLE, DM, (bf16*)(ws + WS_WPLE + L * 512 * KiB), scr, r, F.lane);
        }
    }
    const int gt = gw * 64 + F.lane, NT = NGW * 64;
    { const GAS f32x4* p4 = (const GAS f32x4*)A.in[1] + (size_t)PART * (M * DPLE / 4); GAS v4u* dst = (GAS v4u*)(ws + WS_PB) + (size_t)PART * (M * DPLE / 8);
      for (int i0 = gt; i0 < M * DPLE / 8; i0 += 4 * NT) { f32x4 a[4], b[4];
#pragma unroll
          for (int q = 0; q < 4; ++q) { const int i = i0 + q * NT; if (i < M * DPLE / 8) { a[q] = __builtin_nontemporal_load(p4 + 2 * (size_t)i); b[q] = __builtin_nontemporal_load(p4 + 2 * (size_t)i + 1); } }
#pragma unroll
          for (int q = 0; q < 4; ++q) { const int i = i0 + q * NT; if (i < M * DPLE / 8) { v4u o; o.x = pk2(a[q].x, a[q].y); o.y = pk2(a[q].z, a[q].w); o.z = pk2(b[q].x, b[q].y); o.w = pk2(b[q].z, b[q].w); dst[i] = o; } } } }
    if (PART == 1) return;
    {
        const float* sw = A.in[8]; bf16* dsw = (bf16*)(ws + WS_SGUW);
        const float* pw = A.in[6]; bf16* dpw = (bf16*)(ws + WS_POOLWT);
        const float* rb = A.in[5]; float* drb = (float*)(ws + WS_BIAS2);
        constexpr int N_SW = NL * 4 * 128 * 128, N_PW = NL * 4 * 64 * 64, N_RB = NH * NBIAS;
        float v_sw = 0.f, v_pw = 0.f, v_rb = 0.f;
        if (gt < N_SW) v_sw = sw[gt];
        if (gt < N_PW) v_pw = pw[(size_t)(gt >> 12) * 4096 + (gt & 63) * 64 + ((gt >> 6) & 63)];
        if (gt < N_RB) v_rb = rb[t5_bucket(gt % NBIAS) * NH + gt / NBIAS];
        asm volatile("" ::: "memory");
        if (gt < N_SW) dsw[gt] = (bf16)f2bf((gt & 127) <= ((gt >> 7) & 127) ? v_sw : 0.f);
        if (gt < N_PW) dpw[gt] = (bf16)f2bf(v_pw);
        if (gt < N_RB) drb[gt] = v_rb * LOG2E;
        for (int i = gt + NT; i < N_SW; i += NT) { const int t = (i >> 7) & 127, s = i & 127; dsw[i] = (bf16)f2bf(s <= t ? sw[i] : 0.f); }
        for (int i = gt + NT; i < N_PW; i += NT) { const int lg = i >> 12, d = (i >> 6) & 63, c = i & 63; dpw[i] = (bf16)f2bf(pw[(size_t)lg * 4096 + c * 64 + d]); }
        for (int i = gt + NT; i < N_RB; i += NT) { const int h = i / NBIAS, n = i % NBIAS; drb[i] = rb[t5_bucket(n) * NH + h] * LOG2E; }
    }
    { constexpr int XB = 8; const float* x = A.in[0]; bf16* xn = (bf16*)((unsigned char*)A.out + 32 * MiB); float* ssq = (float*)(ws + WS_SSQ);
      for (int mi = 0; mi < M / NGW; mi += XB) { const int m0 = gw * (M / NGW) + mi;
          f32x4 v[XB][4];
#pragma unroll
          for (int r = 0; r < XB; ++r) { const GAS f32x4* xr = (const GAS f32x4*)(x + (size_t)(m0 + r) * DM) + F.lane;
#pragma unroll
              for (int j = 0; j < 4; ++j) v[r][j] = __builtin_nontemporal_load(xr + 64 * j); }
#pragma unroll
          for (int r = 0; r < XB; ++r) { GAS unsigned long long* o8 = (GAS unsigned long long*)(xn + (size_t)(m0 + r) * DM) + F.lane;
              float s = 0.f;
#pragma unroll
              for (int j = 0; j < 4; ++j) { const f32x4 w = v[r][j]; s += (w.x * w.x + w.y * w.y) + (w.z * w.z + w.w * w.w);
                  o8[64 * j] = (unsigned long long)pk2(w.x, w.y) | ((unsigned long long)pk2(w.z, w.w) << 32); }
              s = wave_sum(s);
              if (F.lane == 0) *(GAS f32x4*)(ssq + (size_t)(m0 + r) * 4) = (f32x4){s, 0.f, 0.f, 0.f}; }
      } }
}
typedef float f32x16 __attribute__((ext_vector_type(16)));
typedef short s16x4 __attribute__((ext_vector_type(4)));
typedef short v4i16_t __attribute__((ext_vector_type(4)));
constexpr int A_K = 0, A_V = 32768, A_ROWTAB = 65536, A_WSF = 66560, A_OST = 68608, A_BIAS = 109312, A_PREF = 102400, A_NT = 104960, A_UD = 107008, A_NN = 107264;
#ifndef ATT_THR
#define ATT_THR 8.0f
#endif
constexpr int NREV = 448;
constexpr int NEAR_OFF = 8064;
__device__ __forceinline__ int crow(int r, int hi) { return (r & 3) + 8 * (r >> 2) + 4 * hi; }
__device__ __forceinline__ unsigned cvtpk_s(float lo, float hi) { typedef float f2 __attribute__((ext_vector_type(2))); typedef __bf16 b2 __attribute__((ext_vector_type(2))); f2 v = {lo, hi}; b2 b = __builtin_convertvector(v, b2); return __builtin_bit_cast(unsigned, b); }
__device__ __forceinline__ s16x4 vtr(const LAS unsigned char* p) { return __builtin_bit_cast(s16x4, __builtin_amdgcn_ds_read_tr16_b64_v4i16((LAS v4i16_t*)p)); }
__device__ __forceinline__ float swap_max(float m) { auto rr = __builtin_amdgcn_permlane32_swap(__float_as_uint(m), __float_as_uint(m), false, false); return __builtin_fmaxf(__uint_as_float(rr[0]), __uint_as_float(rr[1])); }
#ifdef FAR_SPLAT
#define FARC bfar
#else
#define FARC 0.f
#endif
#ifdef NO_ASM_MAX
__device__ __forceinline__ float max3f_(float a, float b, float c) { return __builtin_fmaxf(__builtin_fmaxf(a, b), c); }
#else
__device__ __forceinline__ float max3f_(float a, float b, float c) { float r; asm("v_max3_f32 %0, %1, %2, %3" : "=v"(r) : "v"(a), "v"(b), "v"(c)); return r; }
#endif
__device__ __forceinline__ float swap_add(float m) { auto rr = __builtin_amdgcn_permlane32_swap(__float_as_uint(m), __float_as_uint(m), false, false); return __uint_as_float(rr[0]) + __uint_as_float(rr[1]); }

typedef unsigned short u16;
__device__ __forceinline__ void unpack8(const v4u w, float* f) {
    f[0] = __uint_as_float(w.x << 16); f[1] = __uint_as_float(w.x & 0xffff0000u); f[2] = __uint_as_float(w.y << 16); f[3] = __uint_as_float(w.y & 0xffff0000u);
    f[4] = __uint_as_float(w.z << 16); f[5] = __uint_as_float(w.z & 0xffff0000u); f[6] = __uint_as_float(w.w << 16); f[7] = __uint_as_float(w.w & 0xffff0000u);
}
typedef unsigned v2u __attribute__((ext_vector_type(2)));
constexpr int SGU_PITCH = 272, POOL_PITCH = 528;
constexpr int SGU_ST_OFF = 132096;
constexpr int N_GATE_UNITS = 16 * 31, N_POOL_WU = (M / 32) * 4, N_SGU_WU = (M / 128) * 4 * 4;

__device__ __forceinline__ bf16x8 tr_frag(const LAS unsigned char* blk, const int lane) {
    const int hi = lane >> 5; const LAS unsigned char* p = blk + ((lane >> 4) & 1) * 32 + (lane & 3) * 8 + (4 * hi + ((lane & 15) >> 2)) * 64;
    const s16x4 lo = vtr(p), hh = vtr(p + 512);
    return (bf16x8){lo[0], lo[1], lo[2], lo[3], hh[0], hh[1], hh[2], hh[3]};
}
__device__ __forceinline__ bf16x8 ld_perm8(const bf16* p) {
    const v2u a = *(const v2u*)p, b = *(const v2u*)(p + 8); const v4u w = (v4u){a.x, a.y, b.x, b.y}; return __builtin_bit_cast(bf16x8, w);
}
__device__ __forceinline__ void pool_wave(Frame& F, const Args& A, const int L, const int wu) {
    unsigned char* ws = A.ws; const bf16* Z = (const bf16*)(ws + WS_Z); bf16* Y = (bf16*)(ws + WS_XN);
    const int lane = F.lane, r32 = lane & 31, hi = lane >> 5, gi = wu & 3, tile = wu >> 2, m0 = tile * 32, t0 = m0 & (SEQ - 1), w = 2 << gi;
    LAS unsigned char* X = F.lds + F.wave * 16384;
#pragma unroll
    for (int k = 0; k < 6; ++k) { const int p = lane + 64 * k, row = p >> 3, pc = p & 7; const int ts = t0 - 16 + row;
        v4u v = (v4u){0u, 0u, 0u, 0u};
        if (ts >= 0) v = *(const v4u*)(Z + (size_t)(m0 - 16 + row) * DIN + ZXB + gi * 64 + pc * 8);
        *(LAS v4u*)(X + (pc >> 2) * 4096 + (row >> 4) * 1024 + (row & 15) * 64 + (pc & 3) * 16) = v; }
    const bf16* WT = (const bf16*)(ws + WS_POOLWT) + (size_t)(L * 4 + gi) * 4096;
    const float* psc = A.in[7] + (size_t)L * 256 + gi * 64; const size_t m = (size_t)(m0 + r32);
    bf16x8 wfr[2][4]; v2u gwe[2][4]; f32x4 sce[2][4];
#pragma unroll
    for (int dt = 0; dt < 2; ++dt)
#pragma unroll
        for (int q4 = 0; q4 < 4; ++q4) { wfr[dt][q4] = ld_perm8(WT + (dt * 32 + r32) * 64 + 16 * q4 + 4 * hi); const int d4 = dt * 32 + 8 * q4 + 4 * hi;
            gwe[dt][q4] = *(const v2u*)(Z + m * DIN + ZGB + gi * 64 + d4); sce[dt][q4] = *(const f32x4*)(psc + d4); }
    const int tt = t0 + r32; const float inv = 1.f / (float)((tt + 1 < w) ? tt + 1 : w);
    bf16x8 bnd[3];
#pragma unroll
    for (int ks = 0; ks < 3; ++ks) { unsigned wv[4];
#pragma unroll
        for (int jj = 0; jj < 4; ++jj) { float c2[2];
#pragma unroll
            for (int e = 0; e < 2; ++e) { const int j = 2 * jj + e, sl = 16 * ks + 8 * (j >> 2) + 4 * hi + (j & 3), d = r32 + 16 - sl, sa = t0 - 16 + sl;
                c2[e] = ((d >= 0 && d < w && sa >= 0) ? inv : 0.f) - (d == 0 ? 1.f : 0.f); }
            wv[jj] = pk2(c2[0], c2[1]); }
        bnd[ks] = __builtin_bit_cast(bf16x8, (v4u){wv[0], wv[1], wv[2], wv[3]}); }
    f32x16 pt[2];
#pragma unroll
    for (int mt = 0; mt < 2; ++mt) {
#pragma unroll
        for (int r = 0; r < 16; ++r) pt[mt][r] = 0.f;
#pragma unroll
        for (int ks = 0; ks < 3; ++ks) pt[mt] = __builtin_amdgcn_mfma_f32_32x32x16_bf16(tr_frag(X + mt * 4096 + ks * 1024, lane), bnd[ks], pt[mt], 0, 0, 0);
    }
    f32x16 yt[2];
#pragma unroll
    for (int dt = 0; dt < 2; ++dt) {
#pragma unroll
        for (int r = 0; r < 16; ++r) yt[dt][r] = 0.f;
#pragma unroll
        for (int s2 = 0; s2 < 4; ++s2) { const int mt = s2 >> 1, rb = 8 * (s2 & 1);
            const v4u pw = (v4u){cvtpk_s(pt[mt][rb + 0], pt[mt][rb + 1]), cvtpk_s(pt[mt][rb + 2], pt[mt][rb + 3]), cvtpk_s(pt[mt][rb + 4], pt[mt][rb + 5]), cvtpk_s(pt[mt][rb + 6], pt[mt][rb + 7])};
            yt[dt] = __builtin_amdgcn_mfma_f32_32x32x16_bf16(wfr[dt][s2], __builtin_bit_cast(bf16x8, pw), yt[dt], 0, 0, 0); }
    }
#pragma unroll
    for (int dt = 0; dt < 2; ++dt)
#pragma unroll
        for (int g = 0; g < 4; ++g) { const int d4 = dt * 32 + 8 * g + 4 * hi;
            const v2u gw = gwe[dt][g]; const f32x4 sc = sce[dt][g];
            const float o0 = yt[dt][4 * g + 0] * sc[0] * silu_f(__uint_as_float(gw.x << 16)), o1 = yt[dt][4 * g + 1] * sc[1] * silu_f(__uint_as_float(gw.x & 0xffff0000u));
            const float o2 = yt[dt][4 * g + 2] * sc[2] * silu_f(__uint_as_float(gw.y << 16)), o3 = yt[dt][4 * g + 3] * sc[3] * silu_f(__uint_as_float(gw.y & 0xffff0000u));
            v2u o; o.x = pk2(o0, o1); o.y = pk2(o2, o3);
            *(v2u*)(Y + m * DM + 512 + gi * 64 + d4) = o; }
}
__device__ __forceinline__ void sgu_wave(Frame& F, const Args& A, const int L, const int wu) {
    unsigned char* ws = A.ws; const bf16* Z = (const bf16*)(ws + WS_Z); bf16* Y = (bf16*)(ws + WS_XN);
    const int lane = F.lane, r32 = lane & 31, hi = lane >> 5, nt = wu & 3, hh = (wu >> 2) & 3, chunk = wu >> 4, m0 = chunk * 128;
    LAS unsigned char* X = F.lds + F.wave * 16384;
    const float* vst = (const float*)(ws + WS_STATS);
    const bf16* W = (const bf16*)(ws + WS_SGUW) + (size_t)(L * 4 + hh) * 128 * 128;
    const bf16* wrow = W + (size_t)(nt * 32 + r32) * 128 + 4 * hi;
    const int lim = 2 * nt + 2;
    bf16x8 bw[8];
#pragma unroll
    for (int ks = 0; ks < 8; ++ks) if (ks < lim) bw[ks] = ld_perm8(wrow + 16 * ks);
    const int tl = nt * 32 + r32; const size_t m = (size_t)(m0 + tl);
    const float bb = (A.in[9] + (size_t)(L * 4 + hh) * 128)[tl];
    v2u uw[2][4];
#pragma unroll
    for (int mt = 0; mt < 2; ++mt)
#pragma unroll
        for (int g = 0; g < 4; ++g) { const int c4 = hh * 64 + mt * 32 + 8 * g + 4 * hi; uw[mt][g] = *(const v2u*)(Z + m * DIN + ZUC + c4); }
    const float* gp0 = (const float*)(ws + WS_GCPART) + m * 256, * gp1 = gp0 + (size_t)M * 256;
    const f32x4 s4 = *(const f32x4*)((const float*)(ws + WS_SSQ) + m * 4);
    const float rsm = 1.0f / sqrtf(((s4[0] + s4[1]) + (s4[2] + s4[3])) * (1.0f / 1024.0f) + 1e-6f);
    LAS float* stt = (LAS float*)(F.lds + SGU_ST_OFF + F.wave * 1024);
    const int nrows = 32 * nt + 32, npc = 4 * (nt + 1);
    f32x4 sa[2], sb[2];
#pragma unroll
    for (int q2 = 0; q2 < 2; ++q2) { const int row = lane + 64 * q2; if (row < nrows) { sa[q2] = *(const f32x4*)(vst + (size_t)(m0 + row) * 8); sb[q2] = *(const f32x4*)(vst + (size_t)(m0 + row) * 8 + 4); } }
    v4u dat[16];
#pragma unroll
    for (int k = 0; k < 16; ++k) if (k < npc) { const int p = lane + 64 * k, row = p >> 3, pc = p & 7; dat[k] = *(const v4u*)(Z + (size_t)(m0 + row) * DIN + ZVC + hh * 64 + pc * 8); }
#pragma unroll
    for (int q2 = 0; q2 < 2; ++q2) { const int row = lane + 64 * q2; if (row < nrows) {
        const float mu = ((sa[q2][0] + sa[q2][2]) + (sb[q2][0] + sb[q2][2])) * (1.f / 256.f), ex2 = ((sa[q2][1] + sa[q2][3]) + (sb[q2][1] + sb[q2][3])) * (1.f / 256.f);
        stt[2 * row] = mu; stt[2 * row + 1] = 1.0f / sqrtf(fmaxf(ex2 - mu * mu, 0.f) + 1e-6f); } }
#pragma unroll
    for (int k = 0; k < 16; ++k) if (k < npc) { const int p = lane + 64 * k, row = p >> 3, pc = p & 7;
        const float mu = stt[2 * row], rstd = stt[2 * row + 1];
        float f[8]; unpack8(dat[k], f);
        v4u o; o.x = pk2((f[0] - mu) * rstd, (f[1] - mu) * rstd); o.y = pk2((f[2] - mu) * rstd, (f[3] - mu) * rstd); o.z = pk2((f[4] - mu) * rstd, (f[5] - mu) * rstd); o.w = pk2((f[6] - mu) * rstd, (f[7] - mu) * rstd);
        *(LAS v4u*)(X + (row >> 6) * 8192 + (pc >> 2) * 4096 + ((row >> 4) & 3) * 1024 + (row & 15) * 64 + (pc & 3) * 16) = o; }
    f32x4 ga[2][4], gb[2][4];
#pragma unroll
    for (int mt = 0; mt < 2; ++mt)
#pragma unroll
        for (int g = 0; g < 4; ++g) { const int c4 = hh * 64 + mt * 32 + 8 * g + 4 * hi; ga[mt][g] = *(const f32x4*)(gp0 + c4); gb[mt][g] = *(const f32x4*)(gp1 + c4); }
    f32x16 acc[2];
#pragma unroll
    for (int r = 0; r < 16; ++r) { acc[0][r] = 0.f; acc[1][r] = 0.f; }
#pragma unroll
    for (int ks = 0; ks < 8; ++ks) if (ks < lim) {
        const LAS unsigned char* blk = X + (ks >> 2) * 8192 + (ks & 3) * 1024;
        acc[0] = __builtin_amdgcn_mfma_f32_32x32x16_bf16(tr_frag(blk, lane), bw[ks], acc[0], 0, 0, 0);
        acc[1] = __builtin_amdgcn_mfma_f32_32x32x16_bf16(tr_frag(blk + 4096, lane), bw[ks], acc[1], 0, 0, 0);
    }
#pragma unroll
    for (int mt = 0; mt < 2; ++mt) {
#pragma unroll
        for (int g = 0; g < 4; ++g) { const int c4 = hh * 64 + mt * 32 + 8 * g + 4 * hi; const v2u u_ = uw[mt][g]; const f32x4 gc = (ga[mt][g] + gb[mt][g]) * rsm;
            const float o0 = __uint_as_float(u_.x << 16) * (acc[mt][4 * g + 0] + bb) * silu_f(gc[0]);
            const float o1 = __uint_as_float(u_.x & 0xffff0000u) * (acc[mt][4 * g + 1] + bb) * silu_f(gc[1]);
            const float o2 = __uint_as_float(u_.y << 16) * (acc[mt][4 * g + 2] + bb) * silu_f(gc[2]);
            const float o3 = __uint_as_float(u_.y & 0xffff0000u) * (acc[mt][4 * g + 3] + bb) * silu_f(gc[3]);
            v2u o; o.x = pk2(o0, o1); o.y = pk2(o2, o3);
            *(v2u*)(Y + m * DM + 768 + c4) = o; }
    }
}
__device__ __forceinline__ void gate_pair(Frame& F, const Args& A, const int L, const int ua, const int ub, const bool first) {
    unsigned char* ws = A.ws; const bf16* Z = (const bf16*)(ws + WS_Z);
    const int tid = F.tid, lane = F.lane, wid = F.wave, r32 = lane & 31, hi = lane >> 5, hf = wid >> 2, w4 = wid & 3, t4 = tid & 255;
    const int u = hf ? ub : ua; const bool act = u >= 0; const int uu = act ? u : 0, bh = uu / 31, i = 1 + uu % 31, b = bh >> 3, h = bh & 7;
    LAS unsigned char* lb = F.lds + hf * 12288;
    LAS unsigned char* kmh = lb; LAS unsigned char* kml = lb + 4096;
    LAS int* cnt = (LAS int*)(lb + 8192); LAS int* base = (LAS int*)(lb + 8448);
    const float* ksum = (const float*)(ws + WS_CTL + CTL_KSUM) + (size_t)L * 64 * 512;
    bf16x8 qr[2][4];
    if (act) {
#pragma unroll
        for (int k = 0; k < 8; ++k) { const int e = t4 + 256 * k, j = e >> 6, d = e & 63;
            const float v = (j < i) ? ksum[(size_t)(b * 32 + j) * 512 + h * 64 + d] : 0.f;
            const unsigned vh = f2bf(v), vl = f2bf(v - __uint_as_float(vh << 16));
            *(LAS bf16*)(kmh + (d >> 3) * 512 + j * 16 + (d & 7) * 2) = (bf16)vh; *(LAS bf16*)(kml + (d >> 3) * 512 + j * 16 + (d & 7) * 2) = (bf16)vl; }
        if (t4 < 33) cnt[t4] = 0;
#pragma unroll
        for (int t = 0; t < 2; ++t) { const bf16* qp = Z + (size_t)(b * SEQ + i * 256 + 64 * w4 + 32 * t + r32) * DIN + ZQ + h * 64 + hi * 8;
#pragma unroll
            for (int d0 = 0; d0 < 4; ++d0) qr[t][d0] = *(const bf16x8*)(qp + d0 * 16); }
    }
    __syncthreads();
    const int np = i < 3 ? i : 3;
    int jj[2][3], cc[2][3], pos[2][3];
#pragma unroll
    for (int t = 0; t < 2; ++t) { jj[t][0] = jj[t][1] = jj[t][2] = 0; cc[t][0] = cc[t][1] = cc[t][2] = 0; pos[t][0] = pos[t][1] = pos[t][2] = 0; }
    if (act) {
#pragma unroll
        for (int t = 0; t < 2; ++t) {
            f32x16 p;
#pragma unroll
            for (int r = 0; r < 16; ++r) p[r] = 0.f;
#pragma unroll
            for (int d0 = 0; d0 < 4; ++d0) {
                const bf16x8 ah = *(const LAS bf16x8*)(kmh + (2 * d0 + hi) * 512 + r32 * 16), al = *(const LAS bf16x8*)(kml + (2 * d0 + hi) * 512 + r32 * 16);
                p = __builtin_amdgcn_mfma_f32_32x32x16_bf16(ah, qr[t][d0], p, 0, 0, 0);
                p = __builtin_amdgcn_mfma_f32_32x32x16_bf16(al, qr[t][d0], p, 0, 0, 0);
            }
            float g0 = -INFINITY, g1 = -INFINITY, g2 = -INFINITY; int j0 = 0, j1 = 0, j2 = 0;
#define TOP3_INS(gv, jv) do { const float g_ = (gv); const int j_ = (jv); \
        if (g_ > g0) { g2 = g1; j2 = j1; g1 = g0; j1 = j0; g0 = g_; j0 = j_; } else if (g_ > g1) { g2 = g1; j2 = j1; g1 = g_; j1 = j_; } else if (g_ > g2) { g2 = g_; j2 = j_; } } while (0)
#pragma unroll
            for (int r = 0; r < 16; ++r) { const int j = crow(r, hi); TOP3_INS(j < i ? p[r] : -INFINITY, j); }
            {
                const auto a0 = __builtin_amdgcn_permlane32_swap(__float_as_uint(g0), __float_as_uint(g0), false, false), a1 = __builtin_amdgcn_permlane32_swap(__float_as_uint(g1), __float_as_uint(g1), false, false),
                           a2 = __builtin_amdgcn_permlane32_swap(__float_as_uint(g2), __float_as_uint(g2), false, false);
                const auto b0 = __builtin_amdgcn_permlane32_swap((unsigned)j0, (unsigned)j0, false, false), b1 = __builtin_amdgcn_permlane32_swap((unsigned)j1, (unsigned)j1, false, false),
                           b2 = __builtin_amdgcn_permlane32_swap((unsigned)j2, (unsigned)j2, false, false);
                const int sel = hi ? 0 : 1;
                const float h0 = __uint_as_float(a0[sel]), h1 = __uint_as_float(a1[sel]), h2 = __uint_as_float(a2[sel]); const int k0 = (int)b0[sel], k1 = (int)b1[sel], k2 = (int)b2[sel];
                TOP3_INS(h0, k0); TOP3_INS(h1, k1); TOP3_INS(h2, k2);
            }
#undef TOP3_INS
            const bool nq = 64 * w4 + 32 * t + r32 < 127;
            jj[t][0] = j0; jj[t][1] = j1; jj[t][2] = j2;
            cc[t][0] = (nq && j0 == i - 1) ? 32 : j0; cc[t][1] = (nq && j1 == i - 1) ? 32 : j1; cc[t][2] = (nq && j2 == i - 1) ? 32 : j2;
            if (hi == 0) {
                pos[t][0] = __hip_atomic_fetch_add(cnt + cc[t][0], 1, __ATOMIC_RELAXED, __HIP_MEMORY_SCOPE_WORKGROUP);
                if (np > 1) pos[t][1] = __hip_atomic_fetch_add(cnt + cc[t][1], 1, __ATOMIC_RELAXED, __HIP_MEMORY_SCOPE_WORKGROUP);
                if (np > 2) pos[t][2] = __hip_atomic_fetch_add(cnt + cc[t][2], 1, __ATOMIC_RELAXED, __HIP_MEMORY_SCOPE_WORKGROUP);
            }
        }
    }
    __syncthreads();
    if (act && t4 < i) base[t4] = first ? atomicAdd((int*)(ws + WS_CTL + CTL_NTOT) + L * 512 + bh * 32 + t4, cnt[t4]) : 0;
    if (act && t4 == 32) { base[32] = NEAR_OFF; if (first) ((int*)(ws + WS_CTL + CTL_NNEAR))[L * 512 + bh * 32 + i - 1] = cnt[32]; }
    __syncthreads();
    if (act && hi == 0 && first) {
        u16* Lg = (u16*)(ws + WS_LISTS) + (size_t)bh * 32 * 8192;
#pragma unroll
        for (int t = 0; t < 2; ++t) { const int tok = i * 256 + 64 * w4 + 32 * t + r32;
            Lg[(size_t)jj[t][0] * 8192 + base[cc[t][0]] + pos[t][0]] = (u16)tok;
            if (np > 1) Lg[(size_t)jj[t][1] * 8192 + base[cc[t][1]] + pos[t][1]] = (u16)(tok | (1 << 13));
            if (np > 2) Lg[(size_t)jj[t][2] * 8192 + base[cc[t][2]] + pos[t][2]] = (u16)(tok | (2 << 13)); }
    }
    __syncthreads();
}
__device__ __forceinline__ void pool_units(Frame& F, const Args& A, const int L) {
    const int gwv = F.vcu * NWAVES + F.wave, NGW = F.G * NWAVES;
    for (int rp = 0; rp < REP_POOL; ++rp)
    for (int wu = gwv; wu < N_POOL_WU; wu += NGW) pool_wave(F, A, L, wu);
}
__device__ __forceinline__ void sgu_units(Frame& F, const Args& A, const int L) {
    const int gwv = F.vcu * NWAVES + F.wave, NGW = F.G * NWAVES;
    for (int rp = 0; rp < REP_SGU; ++rp)
    for (int wu = gwv; wu < N_SGU_WU; wu += NGW) sgu_wave(F, A, L, wu);
}
__device__ __forceinline__ void mix_phase(Frame& F, const Args& A, const int L, const bool first = true) {
    for (int rp = 0; rp < REP_GATE; ++rp)
    for (int u = blockIdx.x; u < N_GATE_UNITS / 2; u += F.G) gate_pair(F, A, L, u, u + N_GATE_UNITS / 2, first && rp == 0);
    sgu_units(F, A, L);
    __syncthreads();
}
__device__ __forceinline__ void attn_wave_chunk(Frame& F, const Args& A, const int bh, const int j, const int c, const int ec, const bf16x8 (&qr)[4]) {
    unsigned char* ws = A.ws;
    const int lane = F.lane, wid = F.wave, r32 = lane & 31, hi = lane >> 5;
    LAS unsigned char* lds = F.lds; LAS float* bl = (LAS float*)(lds + A_BIAS);
    const int kbase = 256 * j;
    if (__all(((ec >> 20) & 1) == 0)) return;
    const int ntile = (c == 0) ? (wid >> 1) + 1 : 4;
    const bool nearb = (c != 1);
    float m = 0.f, l = 0.f; f32x16 o[2], negm;
#pragma unroll
    for (int r = 0; r < 16; ++r) { o[0][r] = 0.f; o[1][r] = 0.f; negm[r] = 0.f; }
    LAS float* wsf = (LAS float*)(lds + A_WSF) + wid * 64;
    const LAS unsigned char* kp0 = lds + A_K + hi * 1024 + r32 * 16;
    const LAS unsigned char* vp0 = lds + A_V + ((lane >> 4) & 1) * 32 + (lane & 3) * 8 + (4 * hi + ((lane & 15) >> 2)) * 64;
    if (c == 1) {
    bf16x8 kf[8];
#define AT_KLOAD(KT) do { _Pragma("unroll") for (int i = 0; i < 8; ++i) kf[i] = *(const LAS bf16x8*)(kp0 + (KT) * 8192 + (i >> 1) * 2048 + (i & 1) * 512); } while (0)
#define AT_SBAR() __builtin_amdgcn_sched_barrier(0)
#define AT_PIN(x) asm volatile("" : "+v"(x))
#define AT_ROWMAX(P0, P1, RM) do { asm volatile("s_nop 15\n\ts_nop 7" : "+v"(P0), "+v"(P1)); \
        float ma_ = max3f_(P0[0], P0[1], P1[0]), mb_ = max3f_(P0[2], P0[3], P1[1]); ma_ = max3f_(ma_, P1[2], P1[3]); \
        _Pragma("unroll") for (int r = 4; r < 16; r += 4) { ma_ = max3f_(ma_, P0[r], P0[r + 1]); mb_ = max3f_(mb_, P0[r + 2], P0[r + 3]); ma_ = max3f_(ma_, P1[r], P1[r + 1]); mb_ = max3f_(mb_, P1[r + 2], P1[r + 3]); } \
        RM = max3f_(ma_, mb_, mb_); \
        { auto rr_ = __builtin_amdgcn_permlane32_swap(__float_as_uint(RM), __float_as_uint(RM), false, false); RM = max3f_(__uint_as_float(rr_[0]), __uint_as_float(rr_[1]), __uint_as_float(rr_[1])); } } while (0)
    f32x16 pa0, pa1, pb0, pb1;
    AT_KLOAD(0);
    pa0 = negm; pa1 = negm;
#pragma unroll
    for (int d0 = 0; d0 < 4; ++d0) { pa0 = __builtin_amdgcn_mfma_f32_32x32x16_bf16(kf[2 * d0], qr[d0], pa0, 0, 0, 0); pa1 = __builtin_amdgcn_mfma_f32_32x32x16_bf16(kf[2 * d0 + 1], qr[d0], pa1, 0, 0, 0); }
    if (1 < ntile) AT_KLOAD(1);
    { float rm; AT_ROWMAX(pa0, pa1, rm); m = rm;
#pragma unroll
      for (int r = 0; r < 16; ++r) { pa0[r] = __builtin_amdgcn_exp2f(pa0[r] - rm); pa1[r] = __builtin_amdgcn_exp2f(pa1[r] - rm); negm[r] = -rm; } }
    s16x4 vlo[4], vhi[4]; v4u pw0, pw1, pw2, pw3; bool resc;
#define AT_PKW(P, B) cvtpk_s(P[B], P[B + 1])
#define AT_VFR(i) (bf16x8){vlo[i][0], vlo[i][1], vlo[i][2], vlo[i][3], vhi[i][0], vhi[i][1], vhi[i][2], vhi[i][3]}
#define AT_VRD(VP, i) do { vlo[(i) & 3] = vtr(VP + ((i) >> 2) * 4096 + ((i) & 3) * 1024); vhi[(i) & 3] = vtr(VP + ((i) >> 2) * 4096 + ((i) & 3) * 1024 + 512); } while (0)
#define AT_GAPA(MF, A0, A1, A2, A3, W0, W1, PW) do { MF; sacc += A0; sacc += A1; sacc += A2; sacc += A3; AT_PIN(sacc); W0; W1; AT_SBAR(); } while (0)
#define AT_GAPB(MF, X, B) do { MF; X[B] = __builtin_amdgcn_exp2f(X[B]); X[B + 1] = __builtin_amdgcn_exp2f(X[B + 1]); X[B + 2] = __builtin_amdgcn_exp2f(X[B + 2]); X[B + 3] = __builtin_amdgcn_exp2f(X[B + 3]); AT_PIN(X); AT_SBAR(); } while (0)
#define AT_PV(k, v, d) o[d] = __builtin_amdgcn_mfma_f32_32x32x16_bf16(__builtin_bit_cast(bf16x8, pw##k), AT_VFR((v) & 3), o[d], 0, 0, 0)
#define AT_STEP(C0, C1, P0, P1, T) do { AT_SBAR(); \
        const LAS unsigned char* vp_ = vp0 + ((T) - 1) * 8192; \
        C0 = negm; C1 = negm; \
        AT_VRD(vp_, 0); AT_SBAR(); float sacc = (P0[0] + P0[1]); \
        AT_GAPA(C0 = __builtin_amdgcn_mfma_f32_32x32x16_bf16(kf[0], qr[0], C0, 0, 0, 0), P0[2], P0[3], P0[4], P0[5],     pw0[0] = AT_PKW(P0, 0), pw0[1] = AT_PKW(P0, 2), pw0); \
        AT_GAPA(C1 = __builtin_amdgcn_mfma_f32_32x32x16_bf16(kf[1], qr[0], C1, 0, 0, 0), P0[6], P0[7], P0[8], P0[9],     pw0[2] = AT_PKW(P0, 4), pw0[3] = AT_PKW(P0, 6), pw0); \
        AT_VRD(vp_, 1); AT_SBAR(); AT_GAPA(C0 = __builtin_amdgcn_mfma_f32_32x32x16_bf16(kf[2], qr[1], C0, 0, 0, 0), P0[10], P0[11], P0[12], P0[13], pw1[0] = AT_PKW(P0, 8), pw1[1] = AT_PKW(P0, 10), pw1); \
        AT_GAPA(C1 = __builtin_amdgcn_mfma_f32_32x32x16_bf16(kf[3], qr[1], C1, 0, 0, 0), P0[14], P0[15], P1[0], P1[1],   pw1[2] = AT_PKW(P0, 12), pw1[3] = AT_PKW(P0, 14), pw1); \
        AT_VRD(vp_, 2); AT_SBAR(); AT_GAPA(C0 = __builtin_amdgcn_mfma_f32_32x32x16_bf16(kf[4], qr[2], C0, 0, 0, 0), P1[2], P1[3], P1[4], P1[5],     pw2[0] = AT_PKW(P1, 0), pw2[1] = AT_PKW(P1, 2), pw2); \
        AT_GAPA(C1 = __builtin_amdgcn_mfma_f32_32x32x16_bf16(kf[5], qr[2], C1, 0, 0, 0), P1[6], P1[7], P1[8], P1[9],     pw2[2] = AT_PKW(P1, 4), pw2[3] = AT_PKW(P1, 6), pw2); \
        AT_VRD(vp_, 3); AT_SBAR(); AT_GAPA(C0 = __builtin_amdgcn_mfma_f32_32x32x16_bf16(kf[6], qr[3], C0, 0, 0, 0), P1[10], P1[11], P1[12], P1[13], pw3[0] = AT_PKW(P1, 8), pw3[1] = AT_PKW(P1, 10), pw3); \
        AT_GAPA(C1 = __builtin_amdgcn_mfma_f32_32x32x16_bf16(kf[7], qr[3], C1, 0, 0, 0), P1[14], P1[15], 0.f, 0.f,       pw3[2] = AT_PKW(P1, 12), pw3[3] = AT_PKW(P1, 14), pw3); \
        l += sacc; \
        if ((T) + 1 < ntile) AT_KLOAD((T) + 1); \
        resc = false; \
        { float rm_; AT_ROWMAX(C0, C1, rm_); \
          if (__any(rm_ > ATT_THR)) { const float dl_ = __builtin_fmaxf(rm_, 0.f); m += dl_; \
              _Pragma("unroll") for (int r = 0; r < 16; ++r) { C0[r] -= dl_; C1[r] -= dl_; } \
              _Pragma("unroll") for (int r = 0; r < 16; ++r) negm[r] = -m; \
              const float f_ = __builtin_amdgcn_exp2f(-dl_); l *= f_; if (hi == 0) wsf[r32] = f_; resc = true; } } \
        AT_SBAR(); \
        AT_GAPB(AT_PV(0, 0, 0); AT_VRD(vp_, 4), C0, 0); AT_GAPB(AT_PV(1, 1, 0); AT_VRD(vp_, 5), C0, 4); AT_GAPB(AT_PV(2, 2, 0); AT_VRD(vp_, 6), C0, 8); AT_GAPB(AT_PV(3, 3, 0); AT_VRD(vp_, 7), C0, 12); \
        AT_GAPB(AT_PV(0, 4, 1), C1, 0); AT_GAPB(AT_PV(1, 5, 1), C1, 4); AT_GAPB(AT_PV(2, 6, 1), C1, 8); AT_GAPB(AT_PV(3, 7, 1), C1, 12); \
        if (resc) { _Pragma("unroll") for (int r = 0; r < 16; ++r) { const float fr_ = wsf[crow(r, hi)]; o[0][r] *= fr_; o[1][r] *= fr_; } }     \
    } while (0)
#define AT_DRAIN(P0, P1, T) do { const LAS unsigned char* vp_ = vp0 + (T) * 8192; \
        _Pragma("unroll") for (int i = 0; i < 4; ++i) AT_VRD(vp_, i); \
        float sacc = 0.f; _Pragma("unroll") for (int r = 0; r < 16; ++r) sacc += P0[r] + P1[r]; l += sacc; \
        pw0 = (v4u){AT_PKW(P0, 0), AT_PKW(P0, 2), AT_PKW(P0, 4), AT_PKW(P0, 6)}; pw1 = (v4u){AT_PKW(P0, 8), AT_PKW(P0, 10), AT_PKW(P0, 12), AT_PKW(P0, 14)}; \
        pw2 = (v4u){AT_PKW(P1, 0), AT_PKW(P1, 2), AT_PKW(P1, 4), AT_PKW(P1, 6)}; pw3 = (v4u){AT_PKW(P1, 8), AT_PKW(P1, 10), AT_PKW(P1, 12), AT_PKW(P1, 14)}; \
        AT_PV(0, 0, 0); AT_VRD(vp_, 4); AT_PV(1, 1, 0); AT_VRD(vp_, 5); AT_PV(2, 2, 0); AT_VRD(vp_, 6); AT_PV(3, 3, 0); AT_VRD(vp_, 7); AT_PV(0, 4, 1); AT_PV(1, 5, 1); AT_PV(2, 6, 1); AT_PV(3, 7, 1); } while (0)
    int t = 1;
#pragma unroll 1
    for (; t + 1 < ntile; t += 2) { AT_STEP(pb0, pb1, pa0, pa1, t); AT_STEP(pa0, pa1, pb0, pb1, t + 1); }
    if (t < ntile) { AT_STEP(pb0, pb1, pa0, pa1, t); AT_DRAIN(pb0, pb1, t); }
    else { AT_DRAIN(pa0, pa1, t - 1); }
#undef AT_DRAIN
#undef AT_STEP
#undef AT_PV
#undef AT_GAPB
#undef AT_GAPA
#undef AT_VRD
#undef AT_VFR
#undef AT_PKW
#undef AT_ROWMAX
#undef AT_PIN
#undef AT_SBAR
#undef AT_KLOAD
    } else {
    const int tq = ec & 0xffff; const float bfar = bl[0];
    bf16x8 kf[8];
#pragma unroll
    for (int i = 0; i < 8; ++i) kf[i] = *(const LAS bf16x8*)(kp0 + (i >> 1) * 2048 + (i & 1) * 512);
#pragma unroll
    for (int kt = 0; kt < 4; ++kt) if (kt < ntile) {
        f32x16 p0, p1;
        if (nearb) {
            const int dq = tq - (kbase + kt * 64);
            if (__all(dq - 63 >= 128)) {
                const float cb = bfar - m;
#pragma unroll
                for (int r = 0; r < 16; ++r) { p0[r] = cb; p1[r] = cb; }
            } else {
                const LAS float* rb = bl + (383 - dq + 4 * hi);
#pragma unroll
                for (int r = 0; r < 16; ++r) { p0[r] = rb[(r & 3) + 8 * (r >> 2)] - m; p1[r] = rb[(r & 3) + 8 * (r >> 2) + 32] - m; }
            }
#pragma unroll
            for (int d0 = 0; d0 < 4; ++d0) {
                p0 = __builtin_amdgcn_mfma_f32_32x32x16_bf16(kf[2 * d0], qr[d0], p0, 0, 0, 0);
                p1 = __builtin_amdgcn_mfma_f32_32x32x16_bf16(kf[2 * d0 + 1], qr[d0], p1, 0, 0, 0);
            }
        } else {
            p0 = __builtin_amdgcn_mfma_f32_32x32x16_bf16(kf[0], qr[0], negm, 0, 0, 0);
            p1 = __builtin_amdgcn_mfma_f32_32x32x16_bf16(kf[1], qr[0], negm, 0, 0, 0);
#pragma unroll
            for (int d0 = 1; d0 < 4; ++d0) {
                p0 = __builtin_amdgcn_mfma_f32_32x32x16_bf16(kf[2 * d0], qr[d0], p0, 0, 0, 0);
                p1 = __builtin_amdgcn_mfma_f32_32x32x16_bf16(kf[2 * d0 + 1], qr[d0], p1, 0, 0, 0);
            }
        }
        const LAS unsigned char* vp = vp0 + kt * 8192;
        s16x4 vlo[8], vhi[8];
#pragma unroll
        for (int i = 0; i < 8; ++i) { vlo[i] = vtr(vp + (i >> 2) * 4096 + (i & 3) * 1024); vhi[i] = vtr(vp + (i >> 2) * 4096 + (i & 3) * 1024 + 512); }
        if (kt + 1 < ntile) {
#pragma unroll
            for (int i = 0; i < 8; ++i) kf[i] = *(const LAS bf16x8*)(kp0 + (kt + 1) * 8192 + (i >> 1) * 2048 + (i & 1) * 512);
        }
        asm volatile("s_nop 15\n\ts_nop 7" : "+v"(p0), "+v"(p1));
        float ma = max3f_(p0[0], p0[1], p1[0]), mb = max3f_(p0[2], p0[3], p1[1]); ma = max3f_(ma, p1[2], p1[3]);
#pragma unroll
        for (int r = 4; r < 16; r += 4) { ma = max3f_(ma, p0[r], p0[r + 1]); mb = max3f_(mb, p0[r + 2], p0[r + 3]); ma = max3f_(ma, p1[r], p1[r + 1]); mb = max3f_(mb, p1[r + 2], p1[r + 3]); }
        float rm = max3f_(ma, mb, mb);
        { auto rr = __builtin_amdgcn_permlane32_swap(__float_as_uint(rm), __float_as_uint(rm), false, false); rm = max3f_(__uint_as_float(rr[0]), __uint_as_float(rr[1]), __uint_as_float(rr[1])); }
        if (kt == 0 || __any(rm > ATT_THR)) {
            const float dl = (kt == 0) ? rm : __builtin_fmaxf(rm, 0.f);
            m += dl;
#pragma unroll
            for (int r = 0; r < 16; ++r) { p0[r] -= dl; p1[r] -= dl; }
#pragma unroll
            for (int r = 0; r < 16; ++r) negm[r] = -m;
            if (kt > 0) {
                const float f = __builtin_amdgcn_exp2f(-dl); l *= f;
                if (hi == 0) wsf[r32] = f;
#pragma unroll
                for (int r = 0; r < 16; ++r) { const float fr_ = wsf[crow(r, hi)]; o[0][r] *= fr_; o[1][r] *= fr_; }
            }
        }
        float sacc = 0.f;
#pragma unroll
        for (int r = 0; r < 16; ++r) { p0[r] = __builtin_amdgcn_exp2f(p0[r]); p1[r] = __builtin_amdgcn_exp2f(p1[r]); sacc += p0[r] + p1[r]; }
        l += sacc;
        v4u pw0, pw1, pw2, pw3;
        pw0 = (v4u){cvtpk_s(p0[0], p0[1]), cvtpk_s(p0[2], p0[3]), cvtpk_s(p0[4], p0[5]), cvtpk_s(p0[6], p0[7])};
        pw1 = (v4u){cvtpk_s(p0[8], p0[9]), cvtpk_s(p0[10], p0[11]), cvtpk_s(p0[12], p0[13]), cvtpk_s(p0[14], p0[15])};
        pw2 = (v4u){cvtpk_s(p1[0], p1[1]), cvtpk_s(p1[2], p1[3]), cvtpk_s(p1[4], p1[5]), cvtpk_s(p1[6], p1[7])};
        pw3 = (v4u){cvtpk_s(p1[8], p1[9]), cvtpk_s(p1[10], p1[11]), cvtpk_s(p1[12], p1[13]), cvtpk_s(p1[14], p1[15])};
#define PKV(k) (bf16x8){vlo[k][0], vlo[k][1], vlo[k][2], vlo[k][3], vhi[k][0], vhi[k][1], vhi[k][2], vhi[k][3]}
#pragma unroll
        for (int d0 = 0; d0 < 2; ++d0) {
            o[d0] = __builtin_amdgcn_mfma_f32_32x32x16_bf16(__builtin_bit_cast(bf16x8, pw0), PKV(4 * d0 + 0), o[d0], 0, 0, 0);
            o[d0] = __builtin_amdgcn_mfma_f32_32x32x16_bf16(__builtin_bit_cast(bf16x8, pw1), PKV(4 * d0 + 1), o[d0], 0, 0, 0);
            o[d0] = __builtin_amdgcn_mfma_f32_32x32x16_bf16(__builtin_bit_cast(bf16x8, pw2), PKV(4 * d0 + 2), o[d0], 0, 0, 0);
            o[d0] = __builtin_amdgcn_mfma_f32_32x32x16_bf16(__builtin_bit_cast(bf16x8, pw3), PKV(4 * d0 + 3), o[d0], 0, 0, 0);
        }
#undef PKV
    }
    }
    if (!nearb) m += bl[0];
    const float lt = swap_add(l);
    if (hi == 0) wsf[32 + r32] = lt;
    LAS bf16* stg = (LAS bf16*)(lds + A_OST) + wid * 2048;
#pragma unroll
    for (int r = 0; r < 16; ++r) { const int orow = crow(r, hi); const float rli = __builtin_amdgcn_rcpf(wsf[32 + orow]);
        stg[orow * 64 + r32] = (bf16)f2bf(o[0][r] * rli); stg[orow * 64 + 32 + r32] = (bf16)f2bf(o[1][r] * rli); }
    bf16* OP = (bf16*)(ws + WS_OPART); float* LSE = (float*)(ws + WS_LSE);
    const int e = ((ec >> 20) & 1) ? ec : 0;
    if (hi == 0 && ((ec >> 20) & 1)) LSE[((size_t)bh * SEQ + (ec & 0xffff)) * 4 + ((ec >> 16) & 3)] = m + __builtin_amdgcn_logf(lt);
#pragma unroll
    for (int i = 0; i < 4; ++i) { const int row = i * 8 + (lane >> 3), ch = lane & 7; const int er = __shfl(e, row);
        const v4u v = *(const LAS v4u*)(stg + row * 64 + ch * 8);
        if ((er >> 20) & 1) __builtin_nontemporal_store(v, (v4u*)(OP + (((size_t)bh * SEQ + (er & 0xffff)) * 4 + ((er >> 16) & 3)) * 64 + ch * 8)); }
}
#define AT_LASTB(n) (((((n) - 1) & 255) >> 5) + 1)
#define AT_MERGED(n, nn) ((n) > 0 && (nn) > 0 && AT_LASTB(n) + (((nn) + 31) >> 5) <= 8)
__device__ __forceinline__ void attn_phase(Frame& F, const Args& A, const int L) {
    unsigned char* ws = A.ws; const bf16* Z = (const bf16*)(ws + WS_Z);
    LAS unsigned char* lds = F.lds;
    LAS int* pref = (LAS int*)(lds + A_PREF); LAS int* nts = (LAS int*)(lds + A_NT); LAS int* ud = (LAS int*)(lds + A_UD);
    const int tid = F.tid, lane = F.lane, wid = F.wave, r32 = lane & 31, hi = lane >> 5;
    LAS int* nnr = (LAS int*)(lds + A_NN);
    {   const int n = ((const int*)(ws + WS_CTL + CTL_NTOT))[L * 512 + tid], nn = ((const int*)(ws + WS_CTL + CTL_NNEAR))[L * 512 + tid];
        nts[tid] = n; nnr[tid] = nn;
        if (tid == 0) pref[0] = 0;
        pref[1 + tid] = 1 + ((n + 255) >> 8) + ((nn > 0 && !AT_MERGED(n, nn)) ? 1 : 0);
        __syncthreads();
        for (int off = 1; off < 512; off <<= 1) { const int t = (tid >= off) ? pref[1 + tid - off] : 0; __syncthreads(); pref[1 + tid] += t; __syncthreads(); }
    }
    const int U = pref[512];
    const int u0 = (int)(((long)F.vcu * U) / F.G), u1 = (int)(((long)(F.vcu + 1) * U) / F.G);
    int nU = u1 - u0; if (nU > 64) nU = 64;
    if (tid < nU) { const int u = u0 + tid; int lo = 0, hh = 511;
        while (lo < hh) { const int mid = (lo + hh + 1) >> 1; if (pref[mid] <= u) lo = mid; else hh = mid - 1; }
        const int c = u - pref[lo], nf = (nts[lo] + 255) >> 8; const bool mg = AT_MERGED(nts[lo], nnr[lo]);
        ud[tid] = (lo << 8) | ((c == 0 ? 0 : (c <= nf ? ((c == nf && mg) ? 3 : 1) : 2)) << 6) | (c == 0 ? 0 : (c <= nf ? c - 1 : 0)); }
    __syncthreads();
    const u16* LST = (const u16*)(ws + WS_LISTS);
#define AT_ERAW(k, R) do { const int d_ = ud[k], it_ = d_ >> 8, ty_ = (d_ >> 6) & 3, ci_ = d_ & 63; R = -1; \
        if (ty_ != 0) { const int lb_ = AT_LASTB(nts[it_]); const bool fr_ = (ty_ == 1) || (ty_ == 3 && wid < lb_); \
            const int g_ = fr_ ? 256 * ci_ + 32 * wid + r32 : NEAR_OFF + 32 * (ty_ == 3 ? wid - lb_ : wid) + r32; const bool v_ = fr_ ? (g_ < nts[it_]) : (g_ - NEAR_OFF < nnr[it_]); if (v_) R = (int)LST[(size_t)it_ * 8192 + g_]; } } while (0)
#define AT_EDEC(k, R, E) do { const int d_ = ud[k], ty_ = (d_ >> 6) & 3, j_ = (d_ >> 8) & 31; \
        if (ty_ == 0) E = (256 * j_ + 32 * wid + r32) | (3 << 16) | (1 << 20); \
        else E = (R >= 0) ? ((R & 8191) | ((R >> 13) << 16) | (1 << 20)) : (j_ < 31 ? 256 * j_ + 256 : 256 * j_); } while (0)
#define AT_QLOAD(k, E, Q) do { const int it_ = ud[k] >> 8, bh_ = it_ >> 5; const bf16* qp_ = Z + ((size_t)(bh_ >> 3) * SEQ + ((E) & 0xffff)) * DIN + ZQ + (bh_ & 7) * 64 + hi * 8; \
        _Pragma("unroll") for (int d0 = 0; d0 < 4; ++d0) Q[d0] = *(const bf16x8*)(qp_ + d0 * 16); } while (0)
#define AT_KVLOAD(it) do { const int bh_ = (it) >> 5, j_ = (it) & 31; const bf16* Zb_ = Z + (size_t)(bh_ >> 3) * SEQ * DIN + (bh_ & 7) * 64; \
        _Pragma("unroll") for (int k_ = 0; k_ < 4; ++k_) { kreg[k_] = *(const v4u*)(Zb_ + (size_t)(256 * j_ + 32 * wid + 8 * k_ + (lane >> 3)) * DIN + ZK + (lane & 7) * 8);     \
            vreg[k_] = *(const v4u*)(Zb_ + (size_t)(256 * j_ + 64 * k_ + 16 * (wid & 3) + (lane >> 2)) * DIN + ZV + (wid >> 2) * 32 + (lane & 3) * 8); } } while (0)
    int e1 = 0, r2 = -1;
    if (nU > 0) { int r0; AT_ERAW(0, r0); AT_EDEC(0, r0, e1); }
    if (nU > 1) AT_ERAW(1, r2);
    int cur = -1;
    for (int k = 0; k < nU; ++k) {
        const int d = ud[k], item = __builtin_amdgcn_readfirstlane(d >> 8), c0 = __builtin_amdgcn_readfirstlane((d >> 6) & 3), bh = item >> 5, j = item & 31;
        const int c = (c0 == 3) ? ((wid < __builtin_amdgcn_readfirstlane(AT_LASTB(nts[item]))) ? 1 : 2) : c0;
        const int ec = e1; bf16x8 qc[4];
        AT_QLOAD(k, ec, qc);
        if (k + 1 < nU) { AT_EDEC(k + 1, r2, e1); }
        if (k + 2 < nU) AT_ERAW(k + 2, r2);
        if (item != cur) {
            v4u kreg[4], vreg[4]; AT_KVLOAD(item);
            __syncthreads();
            if (tid < NREV) { const int dd = 383 - tid; ((LAS float*)(lds + A_BIAS))[tid] = dd < 0 ? -INFINITY : ((const float*)(ws + WS_BIAS2))[(bh & 7) * NBIAS + (dd < 128 ? dd : 128)]; }
#pragma unroll
            for (int k_ = 0; k_ < 4; ++k_) { { const int rl_ = 32 * wid + 8 * k_ + (lane >> 3); *(LAS v4u*)(lds + A_K + (rl_ >> 6) * 8192 + (lane & 7) * 1024 + (rl_ & 63) * 16) = kreg[k_]; }
                *(LAS v4u*)(lds + A_V + k_ * 8192 + wid * 1024 + lane * 16) = vreg[k_]; }
            __syncthreads();
            cur = item;
        }
        attn_wave_chunk(F, A, bh, j, c, ec, qc);
    }
#undef AT_ERAW
#undef AT_LASTB
#undef AT_MERGED
#undef AT_EDEC
#undef AT_QLOAD
#undef AT_KVLOAD
    __syncthreads();
}
__device__ __forceinline__ void combine_phase(Frame& F, const Args& A) {
    unsigned char* ws = A.ws; const bf16* Z = (const bf16*)(ws + WS_Z); bf16* Y = (bf16*)(ws + WS_XN);
    const bf16* OP = (const bf16*)(ws + WS_OPART); const float* LSE = (const float*)(ws + WS_LSE);
    const int ch = F.tid & 7;
    constexpr int NB = 2;
    for (int it = 0; it < (M * NH) / (F.G * 64); it += NB) {
        f32x4 ls[NB]; v4u op[NB][4], gav[NB]; int mr[NB], hh[NB], npk[NB]; size_t prr[NB];
#pragma unroll
        for (int b = 0; b < NB; ++b) {
            const int mrow = F.vcu * (M / F.G) + (F.tid >> 3), h = it + b, bb = mrow >> 13, t = mrow & (SEQ - 1), own = t >> 8, np = own < 3 ? own : 3;
            const size_t pr = ((size_t)(bb * NH + h) * SEQ + t) * 4;
            mr[b] = mrow; hh[b] = h; npk[b] = np; prr[b] = pr;
            ls[b] = __builtin_nontemporal_load((const f32x4*)(LSE + pr));
#pragma unroll
            for (int s = 0; s < 4; ++s) if (s == 3 || s < np) op[b][s] = __builtin_nontemporal_load((const v4u*)(OP + (pr + s) * 64 + ch * 8));
            gav[b] = __builtin_nontemporal_load((const v4u*)(Z + (size_t)mrow * DIN + ZGA + h * 64 + ch * 8)); }
#pragma unroll
        for (int b = 0; b < NB; ++b) { const int np = npk[b];
            float mx = ls[b][3];
            if (np > 0) mx = __builtin_fmaxf(mx, ls[b][0]); if (np > 1) mx = __builtin_fmaxf(mx, ls[b][1]); if (np > 2) mx = __builtin_fmaxf(mx, ls[b][2]);
            float acc[8], wsum = 0.f;
#pragma unroll
            for (int i = 0; i < 8; ++i) acc[i] = 0.f;
#pragma unroll
            for (int s = 0; s < 4; ++s) {
                if (s == 3 || s < np) { const float w = __builtin_amdgcn_exp2f(ls[b][s] - mx); wsum += w; float f[8]; unpack8(op[b][s], f);
#pragma unroll
                    for (int i = 0; i < 8; ++i) acc[i] += w * f[i]; }
            }
            const float inv = 1.f / wsum; float gaf[8]; unpack8(gav[b], gaf);
            v4u o; o.x = pk2(acc[0] * inv * silu_f(gaf[0]), acc[1] * inv * silu_f(gaf[1])); o.y = pk2(acc[2] * inv * silu_f(gaf[2]), acc[3] * inv * silu_f(gaf[3]));
            o.z = pk2(acc[4] * inv * silu_f(gaf[4]), acc[5] * inv * silu_f(gaf[5])); o.w = pk2(acc[6] * inv * silu_f(gaf[6]), acc[7] * inv * silu_f(gaf[7]));
            *(v4u*)(Y + (size_t)mr[b] * DM + hh[b] * 64 + ch * 8) = o; }
    }
}
__device__ __forceinline__ void xcd_arrive(const XcdBarrier& b) {
    asm volatile("s_waitcnt vmcnt(0)" ::: "memory");
    __syncthreads();
    if (threadIdx.x == 0) {
        unsigned* bar = b.bar;
        __builtin_amdgcn_s_waitcnt(0);
        unsigned nloc = b.st[0], nx = b.st[1];
        if (nloc == 0u) { xcd_barrier_complete(bar, b.x, nloc, nx); b.st[0] = nloc; b.st[1] = nx; }
        const unsigned old = xb_add(&bar[XB_XSUB(b.x)], 1u);
        const unsigned gen = old / nloc;
        b.st[2] = gen;
        if (old + 1u == (gen + 1u) * nloc) {
            __builtin_amdgcn_fence(__ATOMIC_RELEASE, "agent");
            asm volatile("s_waitcnt vmcnt(0)" ::: "memory");
            const unsigned og = xb_add(&bar[XB_TOP], 1u);
            const unsigned tg = og / nx;
            if (og + 1u == (tg + 1u) * nx) xb_add(&bar[XB_TOPGEN], 1u);
            xb_add(&bar[XB_XGEN(b.x)], 1u);
        }
    }
}
__device__ __forceinline__ void xcd_wait(const XcdBarrier& b) {
    if (threadIdx.x == 0) {
        unsigned* bar = b.bar; const unsigned gen = b.st[2];
        XB_SPIN(xb_ld(&bar[XB_TOPGEN]) == gen, bar);
        __builtin_amdgcn_fence(__ATOMIC_ACQUIRE, "agent");
        asm volatile("s_waitcnt vmcnt(0)" ::: "memory");
    }
    __syncthreads();
}
__device__ __forceinline__ void p1_chunk(Frame& F, const Args& A, const int c) {
    unsigned char* ws = A.ws;
    LAS float* scr = (LAS float*)(F.lds + RING_OFF + F.wave * 16384);
    const int gw = F.vcu * NWAVES + F.wave, NGW = F.G * NWAVES;
    constexpr int I_IN = (DM / 64) * (DIN / 32), I_OUT = (DM / 64) * (DM / 32), I_GATE = I_OUT, I_PLE = (DPLE / 64) * (DM / 32);
    constexpr int I_P = M * DPLE / 2048;
    constexpr int N_A = I_OUT + I_GATE + I_IN + I_PLE + I_P, NU = N_A + I_OUT + I_GATE, CH = 1472;
    const int ubeg = c == 0 ? 0 : c == 1 ? CH : c == 2 ? 2 * CH : N_A, uend = c == 0 ? CH : c == 1 ? 2 * CH : c == 2 ? N_A : NU;
    static_assert(2 * CH < N_A, "chunk boundaries");
    for (int u = ubeg + gw; u < uend; u += NGW) {
        int r = u; constexpr int L = 1;
        if (r < I_OUT) { p0_transpose_item(A.in[4], DM, DM, (bf16*)(ws + WS_WOUT), scr, r, F.lane); continue; } r -= I_OUT;
        if (r < I_GATE) { p0_transpose_item(A.in[11], DM, DM, (bf16*)(ws + WS_WGATE), scr, r, F.lane); continue; } r -= I_GATE;
        if (r < I_IN) { p0_transpose_item(A.in[3] + (size_t)L * DM * DIN, DM, DIN, (bf16*)(ws + WS_WIN + L * WIN_BYTES), scr, r, F.lane, A.in[2] + (size_t)L * DM); continue; } r -= I_IN;
        if (r < I_PLE) { p0_transpose_item(A.in[10] + (size_t)L * DPLE * DM, DPLE, DM, (bf16*)(ws + WS_WPLE + L * 512 * KiB), scr, r, F.lane); continue; } r -= I_PLE;
        if (r < I_P) { const GAS f32x4* p4 = (const GAS f32x4*)A.in[1] + (size_t)(M * DPLE / 4); GAS v4u* dst = (GAS v4u*)(ws + WS_PB) + (size_t)(M * DPLE / 8);
            f32x4 a[4], b[4];
#pragma unroll
            for (int q = 0; q < 4; ++q) { const size_t i = (size_t)r * 256 + F.lane + 64 * q; a[q] = __builtin_nontemporal_load(p4 + 2 * i); b[q] = __builtin_nontemporal_load(p4 + 2 * i + 1); }
#pragma unroll
            for (int q = 0; q < 4; ++q) { const size_t i = (size_t)r * 256 + F.lane + 64 * q; v4u o; o.x = pk2(a[q].x, a[q].y); o.y = pk2(a[q].z, a[q].w); o.z = pk2(b[q].x, b[q].y); o.w = pk2(b[q].z, b[q].w); dst[i] = o; }
            continue; } r -= I_P;
        if (r < I_OUT) { p0_transpose_item(A.in[4] + (size_t)L * DM * DM, DM, DM, (bf16*)(ws + WS_WOUT + L * 2 * MiB), scr, r, F.lane); continue; } r -= I_OUT;
        p0_transpose_item(A.in[11] + (size_t)L * DM * DM, DM, DM, (bf16*)(ws + WS_WGATE + L * 2 * MiB), scr, r, F.lane);
    }
}
constexpr int N_PHASES = 13;
#define IN(k) (lo <= (k) && (k) < hi)
#define SEAM(k) do { if (IN(k) && IN((k) + 1)) { for (int rep_ = 0; rep_ < REP_BAR; ++rep_) xcd_barrier(bar); } } while (0)
template <int L> __device__ __forceinline__ void layer_phases(Frame& F, const Args& args, const XcdBarrier& bar, const int lo, const int hi) {
    unsigned char* ws = args.ws;
    constexpr int P = 1 + 6 * L;
    if (IN(P + 0)) {
        const bf16* Ain = (const bf16*)((unsigned char*)args.out + 32 * MiB);
        const bf16* Wt = (const bf16*)(ws + WS_WIN + L * WIN_BYTES);
        pg8::SchedP1 S1; S1.so.init(M, DIN_MAIN, F.G, (int)blockIdx.x); S1.Ain = (const char*)Ain; S1.Wt = (const char*)Wt; S1.Pb = (const char*)((const bf16*)(ws + WS_PB) + (size_t)L * M * DPLE);
        S1.Wp = (const char*)(ws + WS_WPLE + L * 512 * KiB); S1.G = F.G; S1.c = (int)blockIdx.x;
        pg8::EpiP1 E1{pg8::EpiZ{(bf16*)(ws + WS_Z), (const float*)(ws + WS_SSQ), (float*)(ws + WS_CTL + CTL_KSUM) + (size_t)L * 64 * 512, C2, DIN, (float*)(ws + WS_STATS)},
                      pg8::EpiPart{(float*)(ws + WS_GCPART), M}, pg8::EpiT{(bf16*)args.out}};
        pg8::gemm_phase_x<pg8::EpiP1, pg8::SchedP1, PG8_ALIGN>(F.lds + RING_OFF, S1, E1);
#if REP_GEMM1 > 1
        if (REPB) xcd_barrier(bar);
        pg8::gemm_phase_x<pg8::EpiP1, pg8::SchedP1, PG8_ALIGN>(F.lds + RING_OFF, S1, E1);
#endif
    }
    if constexpr (L == 0) { if (IN(P + 0) && IN(P + 1)) { xcd_arrive(bar); p1_chunk(F, args, 0); xcd_wait(bar); } } else SEAM(P + 0);
    if (IN(P + 1)) { for (int rep = 0; rep < REP_MIX; ++rep) mix_phase(F, args, L, rep == 0); }
    if (IN(P + 1) && IN(P + 2)) { xcd_arrive(bar); pool_units(F, args, L); xcd_wait(bar); }
    if (IN(P + 2)) { for (int rep = 0; rep < REP_ATTN; ++rep) attn_phase(F, args, L); }
    if constexpr (L == 0) { if (IN(P + 2) && IN(P + 3)) { xcd_arrive(bar); p1_chunk(F, args, 1); xcd_wait(bar); } } else SEAM(P + 2);
    f32x4 oacc[2][2][4][2];
    pg8::StaticOrder SO; SO.init(M, DM, F.G, (int)blockIdx.x);
    pg8::EpiResAcc EO{(const bf16*)((unsigned char*)args.out + 32 * MiB), (bf16*)(ws + WS_H1B)};
    if (IN(P + 3)) {
        const bool cfirst = (F.vcu & 1) != 0;
        if (cfirst) combine_phase(F, args);
        pg8::Gemm g{(const bf16*)(ws + WS_XN) + 512, (const bf16*)(ws + WS_WOUT + L * 2 * MiB) + 512, M, DM, 512, DM};
        pg8::gemm_phase_acc<pg8::EpiResAcc, pg8::StaticOrder, PG8_ALIGN, PG8_SP2, 1, false>(F.lds + RING_OFF, g, SO, EO, oacc);
        { pg8::Unit u0; if (SO.next(0, u0)) EO.addbase(oacc, u0); }
        if (!cfirst) combine_phase(F, args);
    }
    if constexpr (L == 0) { if (IN(P + 3) && IN(P + 4)) { xcd_arrive(bar); p1_chunk(F, args, 2); xcd_wait(bar); } } else SEAM(P + 3);
    if (IN(P + 4)) {
        pg8::Gemm g{(const bf16*)(ws + WS_XN), (const bf16*)(ws + WS_WOUT + L * 2 * MiB), M, DM, 512, DM};
        pg8::gemm_phase_acc<pg8::EpiResAcc, pg8::StaticOrder, PG8_ALIGN, PG8_SP2, 0, true>(F.lds + RING_OFF, g, SO, EO, oacc);
    }
    if constexpr (L == 0) { if (IN(P + 4) && IN(P + 5)) { xcd_arrive(bar); p1_chunk(F, args, 3); xcd_wait(bar); } } else SEAM(P + 4);
    if (IN(P + 5)) {
        pg8::Gemm g{(const bf16*)(ws + WS_H1B), (const bf16*)(ws + WS_WGATE + L * 2 * MiB), M, DM, DM, DM}; pg8::StaticOrder S; S.init(M, DM, F.G, (int)blockIdx.x);
        if constexpr (L + 1 < NL) {
            pg8::EpiPle E{(const bf16*)args.out, (const bf16*)(ws + WS_H1B), (bf16*)((unsigned char*)args.out + 32 * MiB), (float*)(ws + WS_SSQ)};
            pg8::gemm_phase<pg8::EpiPle, pg8::StaticOrder, false, PG8_SP2>(F.lds + RING_OFF, g, S, E);
#if REP_SIG > 1
            pg8::gemm_phase<pg8::EpiPle, pg8::StaticOrder, false, PG8_SP2>(F.lds + RING_OFF, g, S, E);
#endif
        } else {
            pg8::EpiPleFinal E{(const bf16*)args.out, (const bf16*)(ws + WS_H1B), args.out, args.in[12], (float*)(ws + WS_SSQ), bar};
            pg8::gemm_phase<pg8::EpiPleFinal, pg8::StaticOrder, false, PG8_SP2>(F.lds + RING_OFF, g, S, E);
        }
    }
    SEAM(P + 5);
}
__global__ void __launch_bounds__(NWAVES * 64, 2) skel_fwd(Args args) {
    extern __shared__ __attribute__((aligned(16))) unsigned char lds[];
    Frame F;
    F.lds = (LAS unsigned char*)lds;
    F.MISC = (volatile LAS unsigned*)(F.lds + MISC_OFF);
    F.tid = threadIdx.x; F.lane = F.tid & 63; F.wave = __builtin_amdgcn_readfirstlane(F.tid >> 6);
    F.G = gridDim.x; { const int bx = blockIdx.x; F.vcu = (F.G % 8 == 0) ? (bx % 8) * (F.G / 8) + bx / 8 : bx; }
    F.ctl = (gu32*)(args.ws + WS_CTL);
    for (int u = F.tid; u < (LDS_BYTES - LDSCTL_OFF) / 4; u += NWAVES * 64) ((LAS unsigned*)(F.lds + LDSCTL_OFF))[u] = 0u;
    __syncthreads();
    XcdBarrier bar = xcd_barrier_post((unsigned*)(F.ctl + CW_BAR) + args.li * XCD_BAR_WORDS, F.MISC + 8);
    const int lo = args.ph_lo, hi = args.ph_hi;
    if (IN(0)) { for (int rep = 0; rep < REP_PRO; ++rep) p0_prologue<0>(F, args); }
    SEAM(0);
    layer_phases<0>(F, args, bar, lo, hi);
    layer_phases<1>(F, args, bar, lo, hi);
}
extern "C" void kernel_launch(void* const* d_in, const int* in_sizes, int n_in, void* d_out, int out_size, void* d_ws, size_t ws_size, hipStream_t stream) {
    static int grid = 0;
    if (grid == 0) {
        if (n_in != 13 || in_sizes[0] != M * DM || out_size != M * DM || ws_size < WS_END) { fprintf(stderr, "kernel_launch: unexpected shapes: n_in %d in0 %d out %d ws %zu (need %zu)\n", n_in, n_in > 0 ? in_sizes[0] : -1, out_size, ws_size, (size_t)WS_END); grid = -1; return; }
        int dev = 0, cus = 0, per_cu = 0;
        if (hipGetDevice(&dev) != hipSuccess || hipDeviceGetAttribute(&cus, hipDeviceAttributeMultiprocessorCount, dev) != hipSuccess) { grid = -1; return; }
        if (hipFuncSetAttribute((const void*)skel_fwd, hipFuncAttributeMaxDynamicSharedMemorySize, LDS_BYTES) != hipSuccess) { fprintf(stderr, "kernel_launch: hipFuncSetAttribute failed\n"); grid = -1; return; }
        if (hipOccupancyMaxActiveBlocksPerMultiprocessor(&per_cu, (const void*)skel_fwd, NWAVES * 64, LDS_BYTES) != hipSuccess || per_cu < 1) fprintf(stderr, "kernel_launch: occupancy query reports %d\n", per_cu);
        (void)hipGetLastError();
        grid = cus;
        if (grid != 256) fprintf(stderr, "kernel_launch: %d CUs; this kernel needs 256\n", grid);
    }
    if (grid < 0) return;
    (void)hipMemsetAsync((char*)d_ws + WS_CTL, 0, CTL_ZERO_BYTES, stream);
    Args a{};
    for (int i = 0; i < 13; ++i) a.in[i] = (const float*)d_in[i];
    a.out = (float*)d_out; a.ws = (unsigned char*)d_ws;
    a.ph_lo = 0; a.ph_hi = N_PHASES; a.li = 0;
#ifdef PROBE_K
    a.ph_hi = PROBE_K;
    hipLaunchKernelGGL(skel_fwd, dim3(grid), dim3(NWAVES * 64), LDS_BYTES, stream, a);
    (void)hipMemsetAsync((char*)d_ws + WS_CTL, 0, CTL_ZERO_BYTES, stream);
    a.ph_hi = N_PHASES;
#endif
    hipLaunchKernelGGL(skel_fwd, dim3(grid), dim3(NWAVES * 64), LDS_BYTES, stream, a);
}
```
